# Optimizing an MI355X kernel written in HIP

```python
import math
import jax, jax.numpy as jnp
from jax import lax
import numpy as np

D_MODEL = 1024
BATCH = 8
SEQ = 2048
DEPTH = 1
DEC_BATCH = 128
DEC_SEQ = 1
PAST_LEN = 16384
PAGE_SIZE = 128

D_MIX = D_MODEL
D_S5 = D_MIX // 2
S5_CH = 16
S5_GROUPS = D_S5 // S5_CH
S5_STATE = 64
D_POOL = D_MIX - D_S5
POOL_WINDOWS = (2, 4, 8, 16)
N_POOL = len(POOL_WINDOWS)
POOL_CH = D_POOL // N_POOL
POOL_BUF = max(POOL_WINDOWS) - 1
D_FF = ((8 * D_MODEL // 3 + 127) // 128) * 128
CONV_W = 3
EPS = 1e-6
DT_MIN = 1e-3
DT_MAX = 1e-1

kernel_name = "hymba_s5_pool_convffn_step"


def _rmsnorm(x, g):
    xf = x.astype(jnp.float32)
    y = xf * lax.rsqrt(jnp.mean(xf * xf, axis=-1, keepdims=True) + EPS)
    return (y * g.astype(jnp.float32)).astype(x.dtype)


def _lin_rec_op(e1, e2):
    a1, b1 = e1
    a2, b2 = e2
    return a1 * a2, a2 * b1 + b2


def _s5_mixer(u, h0_re, h0_im, a_re, a_im, log_dt, b_re, b_im, c_re, c_im, d_skip, w_glu):
    f32 = jnp.float32
    n, l, _ = u.shape
    uf = u.astype(f32).reshape(n, l, S5_GROUPS, S5_CH)
    a = lax.complex(a_re.astype(f32), a_im.astype(f32))
    dt_a = jnp.exp(log_dt.astype(f32))[:, None] * a
    a_bar = jnp.exp(dt_a)
    b = lax.complex(b_re.astype(f32), b_im.astype(f32))
    b_bar = ((a_bar - 1.0) / a)[:, :, None] * b
    bu = jnp.einsum('gph,nlgh->nlgp', b_bar, uf.astype(jnp.complex64))
    a_seq = jnp.broadcast_to(a_bar, bu.shape)
    _, h = lax.associative_scan(_lin_rec_op, (a_seq, bu), axis=1)
    steps = jnp.arange(1, l + 1, dtype=f32)[:, None, None]
    h0 = lax.complex(h0_re.astype(f32), h0_im.astype(f32))
    h = h + jnp.exp(steps * dt_a)[None] * h0[:, None]
    c = lax.complex(c_re.astype(f32), c_im.astype(f32))
    y = jnp.real(jnp.einsum('ghp,nlgp->nlgh', c, h)) + d_skip.astype(f32).reshape(S5_GROUPS, S5_CH) * uf
    y = jax.nn.gelu(y.reshape(n, l, D_S5), approximate=False)
    y = y * jax.nn.sigmoid(y @ w_glu.astype(f32))
    h_last = h[:, -1]
    return y.astype(u.dtype), jnp.real(h_last), jnp.imag(h_last)


def _pool_mixer(v, buf, n_past, w_pool, pool_scale):
    f32 = jnp.float32
    n, l, _ = v.shape
    seq = jnp.concatenate([buf.astype(f32), v.astype(f32)], axis=1)
    cs = jnp.concatenate([jnp.zeros((n, 1, D_POOL), f32), jnp.cumsum(seq, axis=1)], axis=1)
    end = cs[:, POOL_BUF + 1:]
    pos = n_past + jnp.arange(l, dtype=jnp.int32) + 1
    means = []
    for gi, w in enumerate(POOL_WINDOWS):
        sl = slice(gi * POOL_CH, (gi + 1) * POOL_CH)
        start = cs[:, POOL_BUF + 1 - w:POOL_BUF + 1 - w + l, sl]
        cnt = jnp.minimum(pos, w).astype(f32)[None, :, None]
        means.append((end[..., sl] - start) / cnt)
    pooled = jnp.concatenate(means, axis=-1) - seq[:, POOL_BUF:]
    z = jnp.einsum('nlgc,gcd->nlgd', pooled.reshape(n, l, N_POOL, POOL_CH), w_pool.astype(f32))
    out = z.reshape(n, l, D_POOL) * pool_scale.astype(f32)
    new_buf = seq[:, -POOL_BUF:]
    return out.astype(v.dtype), new_buf.astype(v.dtype)


def _conv_ffn(x, buf, w_up, conv_w, conv_b, w_down):
    l = x.shape[1]
    hup = x @ w_up
    seq = jnp.concatenate([buf.astype(hup.dtype), hup], axis=1)
    conv = conv_b + sum(conv_w[k] * seq[:, k:k + l] for k in range(CONV_W))
    gate, val = conv[..., :D_FF], conv[..., D_FF:]
    out = (jax.nn.gelu(gate, approximate=False) * val) @ w_down
    return out, seq[:, -(CONV_W - 1):]


def _layer(x, h0_re, h0_im, pool_buf, conv_buf, n_past,
           norm_mix_g, w_in, s5_a_re, s5_a_im, s5_log_dt, s5_b_re, s5_b_im,
           s5_c_re, s5_c_im, s5_d, s5_w_glu, pool_w, pool_scale, w_out,
           norm_ffn_g, ffn_w_up, ffn_conv_w, ffn_conv_b, ffn_w_down):
    h = _rmsnorm(x, norm_mix_g)
    proj = h @ w_in
    u, v = proj[..., :D_S5], proj[..., D_S5:]
    y_s5, new_re, new_im = _s5_mixer(u, h0_re, h0_im, s5_a_re, s5_a_im, s5_log_dt,
                                     s5_b_re, s5_b_im, s5_c_re, s5_c_im, s5_d, s5_w_glu)
    y_pool, new_pool = _pool_mixer(v, pool_buf, n_past, pool_w, pool_scale)
    x = x + jnp.concatenate([y_s5, y_pool], axis=-1) @ w_out
    h = _rmsnorm(x, norm_ffn_g)
    y_ffn, new_conv = _conv_ffn(h, conv_buf, ffn_w_up, ffn_conv_w, ffn_conv_b, ffn_w_down)
    x = x + y_ffn
    return x, new_re, new_im, new_pool, new_conv


def setup_inputs(seed: int = 0) -> dict:
    key = jax.random.key(seed)
    ks = jax.random.split(key, 32)
    f32 = jnp.float32
    nrm = lambda k, s, sc: jax.random.normal(k, s, f32) * sc
    n_idx = jnp.arange(S5_STATE, dtype=f32)
    return {
        "x_prompt": nrm(ks[0], (BATCH, SEQ, D_MODEL), 1.0),
        "x_sample": nrm(ks[1], (DEC_BATCH, DEC_SEQ, D_MODEL), 1.0),
        "state_s5_re": nrm(ks[2], (DEPTH, DEC_BATCH, S5_GROUPS, S5_STATE), 0.3),
        "state_s5_im": nrm(ks[3], (DEPTH, DEC_BATCH, S5_GROUPS, S5_STATE), 0.3),
        "state_pool": nrm(ks[4], (DEPTH, DEC_BATCH, POOL_BUF, D_POOL), 1.0),
        "state_ffn_conv": nrm(ks[5], (DEPTH, DEC_BATCH, CONV_W - 1, 2 * D_FF), 1.0),
        "norm_mix_g": 1.0 + nrm(ks[6], (DEPTH, D_MODEL), 0.02),
        "w_in": nrm(ks[7], (DEPTH, D_MODEL, D_MIX), D_MODEL ** -0.5),
        "s5_a_re": -0.5 + nrm(ks[8], (DEPTH, S5_GROUPS, S5_STATE), 0.01),
        "s5_a_im": math.pi * n_idx + nrm(ks[9], (DEPTH, S5_GROUPS, S5_STATE), 0.01),
        "s5_log_dt": jax.random.uniform(ks[10], (DEPTH, S5_GROUPS), f32,
                                         math.log(DT_MIN), math.log(DT_MAX)),
        "s5_b_re": nrm(ks[11], (DEPTH, S5_GROUPS, S5_STATE, S5_CH), (2 * S5_CH) ** -0.5),
        "s5_b_im": nrm(ks[12], (DEPTH, S5_GROUPS, S5_STATE, S5_CH), (2 * S5_CH) ** -0.5),
        "s5_c_re": nrm(ks[13], (DEPTH, S5_GROUPS, S5_CH, S5_STATE), (2 * S5_STATE) ** -0.5),
        "s5_c_im": nrm(ks[14], (DEPTH, S5_GROUPS, S5_CH, S5_STATE), (2 * S5_STATE) ** -0.5),
        "s5_d": nrm(ks[15], (DEPTH, D_S5), 1.0),
        "s5_w_glu": nrm(ks[16], (DEPTH, D_S5, D_S5), D_S5 ** -0.5),
        "pool_w": nrm(ks[17], (DEPTH, N_POOL, POOL_CH, POOL_CH), POOL_CH ** -0.5),
        "pool_scale": 1.0 + nrm(ks[18], (DEPTH, D_POOL), 0.02),
        "w_out": nrm(ks[19], (DEPTH, D_MIX, D_MODEL), D_MIX ** -0.5),
        "norm_ffn_g": 1.0 + nrm(ks[20], (DEPTH, D_MODEL), 0.02),
        "ffn_w_up": nrm(ks[21], (DEPTH, D_MODEL, 2 * D_FF), D_MODEL ** -0.5),
        "ffn_conv_w": nrm(ks[22], (DEPTH, CONV_W, 2 * D_FF), CONV_W ** -0.5),
        "ffn_conv_b": nrm(ks[23], (DEPTH, 2 * D_FF), 0.02),
        "ffn_w_down": nrm(ks[24], (DEPTH, D_FF, D_MODEL), D_FF ** -0.5),
        "norm_final_g": 1.0 + nrm(ks[25], (D_MODEL,), 0.02),
    }


def reference(x_prompt, x_sample, state_s5_re, state_s5_im, state_pool, state_ffn_conv,
              norm_mix_g, w_in, s5_a_re, s5_a_im, s5_log_dt, s5_b_re, s5_b_im,
              s5_c_re, s5_c_im, s5_d, s5_w_glu, pool_w, pool_scale, w_out,
              norm_ffn_g, ffn_w_up, ffn_conv_w, ffn_conv_b, ffn_w_down, norm_final_g):
    f32 = jnp.float32
    xp, xs = x_prompt, x_sample
    p_re, p_im, p_pool, p_conv = [], [], [], []
    s_re, s_im, s_pool, s_conv = [], [], [], []
    for i in range(DEPTH):
        w = (norm_mix_g[i], w_in[i], s5_a_re[i], s5_a_im[i], s5_log_dt[i], s5_b_re[i],
             s5_b_im[i], s5_c_re[i], s5_c_im[i], s5_d[i], s5_w_glu[i], pool_w[i],
             pool_scale[i], w_out[i], norm_ffn_g[i], ffn_w_up[i], ffn_conv_w[i],
             ffn_conv_b[i], ffn_w_down[i])
        zs = jnp.zeros((BATCH, S5_GROUPS, S5_STATE), f32)
        zp = jnp.zeros((BATCH, POOL_BUF, D_POOL), xp.dtype)
        zc = jnp.zeros((BATCH, CONV_W - 1, 2 * D_FF), xp.dtype)
        xp, a, b, c, d = _layer(xp, zs, zs, zp, zc, 0, *w)
        p_re.append(a); p_im.append(b); p_pool.append(c); p_conv.append(d)
        xs, a, b, c, d = _layer(xs, state_s5_re[i], state_s5_im[i], state_pool[i],
                                state_ffn_conv[i], PAST_LEN, *w)
        s_re.append(a); s_im.append(b); s_pool.append(c); s_conv.append(d)
    y_prompt = _rmsnorm(xp, norm_final_g)
    y_sample = _rmsnorm(xs, norm_final_g)
    return (y_prompt, y_sample,
            jnp.stack(p_re), jnp.stack(p_im), jnp.stack(p_pool), jnp.stack(p_conv),
            jnp.stack(s_re), jnp.stack(s_im), jnp.stack(s_pool), jnp.stack(s_conv))
```

```cpp
#include <hip/hip_runtime.h>
#include <hip/hip_cooperative_groups.h>
#include <cstdio>
#include <cstdint>
namespace cg = cooperative_groups;

constexpr int D = 1024, NB = 8, L = 2048, MP = NB * L  , NS = 128, MTOT = MP + NS  , MPAD = 16640  ;
constexpr int DS5 = 512, NG = 32, NH = 16, NP = 64, DPOOL = 512, FF = 2816, FF2 = 5632;
constexpr int TCH = 16, NCH = L / TCH  , NROW = NB * NCH  ;
constexpr float EPS = 1e-6f;

constexpr size_t O_Y = 0, O_YS = 16777216, O_PRE = 16908288, O_PIM = 16924672, O_PPOOL = 16941056, O_PCONV = 17002496,
                 O_SRE = 17092608, O_SIM = 17354752, O_SPOOL = 17616896, O_SCONV = 18599936;

constexpr size_t MiB = 1u << 20;
constexpr size_t WS_WIN = 0, WS_WGLU = 2 * MiB, WS_WMIX = 2 * MiB + MiB / 2, WS_WUP = 4 * MiB + MiB / 2, WS_WDN = 15 * MiB + MiB / 2;
constexpr size_t WS_KTAB = 21 * MiB, WS_W2 = 21 * MiB + MiB / 4, WS_W3 = 23 * MiB + MiB / 4, WS_ABAR = 25 * MiB + MiB / 4, WS_AT = WS_ABAR + 16384, WS_BBAR = WS_ABAR + 32768;
constexpr size_t WS_CTR = 26 * MiB + 160 * 1024;
constexpr size_t WS_CNT = 26 * MiB + 144 * 1024;
constexpr size_t WS_RINV = 224 * MiB + MiB / 2 + MiB / 4;
constexpr size_t WS_XSLOT = 224 * MiB + MiB / 2;
constexpr size_t WS_BAR = 26 * MiB + 128 * 1024;
constexpr size_t WS_SS = 26 * MiB, WS_USAMP = 26 * MiB + MiB / 4, WS_APW = 26 * MiB + MiB / 2;
constexpr size_t WS_XN = 27 * MiB, WS_UPERM = WS_XN + (size_t)MPAD * D * 2, WS_V = WS_UPERM + 16 * MiB, WS_E = WS_V + (size_t)MPAD * 512 * 4,
                 WS_HIN = WS_E + 16 * MiB, WS_YG = WS_HIN + 8 * MiB, WS_AMIX = WS_YG + (size_t)MPAD * 512 * 2, WS_XMIDB = WS_AMIX + (size_t)MPAD * D * 2,
                 WS_HALO = WS_XMIDB + (size_t)MPAD * D * 2, WS_END = WS_HALO + (size_t)512 * FF2 * 4;
constexpr size_t WS_ACT = WS_XN;
static_assert(WS_END <= 256 * MiB, "ws map");
static_assert(WS_ACT + (size_t)MPAD * FF * 2 <= WS_YG, "ACT overlay must stay below live buffers");

constexpr int LDS_BYTES = 147456;

#define LAS __attribute__((address_space(3)))
typedef unsigned short bf16;
typedef unsigned v4u __attribute__((ext_vector_type(4)));
typedef unsigned v2u __attribute__((ext_vector_type(2)));
typedef float f32x4 __attribute__((ext_vector_type(4)));
typedef float f32x2 __attribute__((ext_vector_type(2)));
typedef short bf16x8 __attribute__((ext_vector_type(8)));
#define LDS_WAIT() asm volatile("s_waitcnt lgkmcnt(0)" ::: "memory")

__device__ __forceinline__ unsigned cvt_pk_bf16(float lo, float hi) { unsigned r; asm volatile("v_cvt_pk_bf16_f32 %0, %1, %2" : "=v"(r) : "v"(lo), "v"(hi)); return r; }
__device__ __forceinline__ float bf2f(unsigned b) { return __uint_as_float(b << 16); }
__device__ __forceinline__ float gelu_exact(float v) { return 0.5f * v * (1.0f + erff(v * 0.70710678118654752f)); }
__device__ __forceinline__ f32x2 gelu_pk(f32x2 v) {
    const f32x2 av = __builtin_elementwise_abs(v), d = av * 0.2316418882f + 1.0f;
    f32x2 t; t.x = __builtin_amdgcn_rcpf(d.x); t.y = __builtin_amdgcn_rcpf(d.y);
    f32x2 q = t * 0.5307027145f + (-0.7265760135f); q = q * t + 0.7107068705f; q = q * t + (-0.142248368f); q = q * t + 0.127414796f; q = q * t;
    const f32x2 s = (v * v) * (-0.72134752044f);
    f32x2 e; e.x = __builtin_amdgcn_exp2f(s.x); e.y = __builtin_amdgcn_exp2f(s.y);
    const f32x2 m = v * (q * e), r = v - m;
    f32x2 o; o.x = v.x < 0.f ? m.x : r.x; o.y = v.y < 0.f ? m.y : r.y; return o;
}
__device__ __forceinline__ f32x4 gelu4(f32x4 v) { f32x2 a = gelu_pk((f32x2){v[0], v[1]}), b = gelu_pk((f32x2){v[2], v[3]}); return (f32x4){a.x, a.y, b.x, b.y}; }
__device__ __forceinline__ float sigmoidf_(float x) { return __builtin_amdgcn_rcpf(1.0f + __expf(-x)); }
__device__ __forceinline__ float wave_sum(float v) {
#pragma unroll
    for (int o = 1; o < 64; o <<= 1) v += __shfl_xor(v, o);
    return v;
}

namespace pg8 {
#define PG8_LAS __attribute__((address_space(3)))
typedef unsigned short bf16_t;
constexpr int BM = 256, BK = 64, HALF = 128, HTB = HALF * BK * 2, STAGE_BYTES = 8 * HTB, NXCD = 8, WGM = 8;
__host__ __device__ __forceinline__ int lds_byte(int r, int c) { const int st = (r >> 4) * 2 + (c >> 5), rr = r & 15, cc = c & 31, ob = rr * 64 + cc * 2; return st * 1024 + (ob ^ (((ob >> 9) & 1) << 5)); }
__host__ __device__ __forceinline__ void stage_rc(int b, int& R, int& C) { const int st = b / 1024, sb = b % 1024, swz = sb ^ (((sb >> 9) & 1) << 5); R = (st >> 1) * 16 + swz / 64; C = (st & 1) * 32 + (swz % 64) / 2; }
__host__ __device__ __forceinline__ int perm32(int rho) { const int n = rho >> 4, i = rho & 15; return 8 * (i >> 2) + 4 * n + (i & 3); }
struct Unit { int pm, pn; };
struct Gemm { const bf16_t* A; const bf16_t* Bt; int M, N, K, ld; };
struct StaticOrder {
    int nM, nN, nwg, G, c, pm_off, lim, L_off;
    __host__ __device__ void init(int M, int N, int G_, int c_, int pm_off_ = 0) { nM = M / BM; nN = N / BM; nwg = nM * nN; G = G_; c = c_; pm_off = pm_off_; lim = nwg; L_off = 0; }
    __host__ __device__ __forceinline__ bool next(int i, Unit& u) const { return from_L(L_off + i * G + c, u); }
    __host__ __device__ __forceinline__ bool from_L(int Lq, Unit& u) const {
        if (Lq >= lim) return false;
        int wgid = Lq; { const int q = nwg / NXCD, r = nwg % NXCD, xcd = wgid % NXCD, off = wgid / NXCD; wgid = (xcd < r ? xcd * (q + 1) : r * (q + 1) + (xcd - r) * q) + off; }
        const int nig = WGM * nN, gid = wgid / nig, fm = gid * WGM, gsz = (nM - fm) < WGM ? (nM - fm) : WGM;
        u.pm = pm_off + fm + ((wgid % nig) % gsz); u.pn = (wgid % nig) / gsz; return true;
    }
    __device__ __forceinline__ void a_ready(const Unit&) const {}
    __device__ __forceinline__ void done(const Unit&) const {}
};
template <class Epi, class Sched, bool ALIGN_EPI = false, bool SP2 = false, int AMODE = 0, bool AFTER_DRAIN = false>
__device__ __forceinline__ void gemm_phase(PG8_LAS unsigned char* lds, const Gemm g, const Sched& S, const Epi& E) {
    int tid_ = threadIdx.x; asm volatile("" : "+v"(tid_));
    const int tid = tid_, wid = __builtin_amdgcn_readfirstlane(tid >> 6), lane = tid & 63, wr = wid >> 2, wc = wid & 3, fr = lane & 15, fq = lane >> 4;
    const int K = g.K, nt = K / BK;
    unsigned voffA[2], voffB[2];
#pragma unroll
    for (int i = 0; i < 2; ++i) { int R, C; stage_rc(tid * 16 + i * 8192, R, C); const int Rb = Epi::PERM ? ((R & ~31) + perm32(R & 31)) : R;
        const int Ra = (AMODE == 1) ? (32 * R - 31 * (R & 1)) : R;
        voffA[i] = (unsigned)(Ra * g.ld + C) * 2u; voffB[i] = (unsigned)(Rb * g.ld + C) * 2u; }
    const size_t kstep = (size_t)(BK * 2);
    const size_t hstepB = (size_t)HALF * g.ld * 2, tstepB = 2 * hstepB;
    const size_t hstepA = (AMODE == 1) ? hstepB * 32 : hstepB, tstepA = 2 * hstepA;
    const unsigned ldsw = (unsigned)wid * 1024u;
    const int aoff = lds_byte(wr * 64 + fr, fq * 8), boff = lds_byte(wc * 32 + fr, fq * 8);
#define PG8_SA(b, h) (((b) * 2 + (h)) * HTB)
#define PG8_SB(b, h) ((4 + (b) * 2 + (h)) * HTB)
#define PG8_STAGE(bufoff, gbase, voff) do { _Pragma("unroll") for (int _i = 0; _i < 2; ++_i) \
        __builtin_amdgcn_global_load_lds((const unsigned*)((const char*)(gbase) + (voff)[_i]), (PG8_LAS unsigned*)(lds + (bufoff) + ldsw + _i * 8192), 16, 0, 0); } while (0)
#define PG8_LDA(dst, b, h) do { _Pragma("unroll") for (int m = 0; m < 4; ++m) _Pragma("unroll") for (int k = 0; k < 2; ++k) dst[m][k] = *(const PG8_LAS bf16x8*)(lds + PG8_SA(b, h) + aoff + m * 2048 + k * 1024); } while (0)
#define PG8_LDB(dst, b, h) do { _Pragma("unroll") for (int n = 0; n < 2; ++n) _Pragma("unroll") for (int k = 0; k < 2; ++k) dst[n][k] = *(const PG8_LAS bf16x8*)(lds + PG8_SB(b, h) + boff + n * 2048 + k * 1024); } while (0)
#define PG8_MMA(ai, bj, At, Bt) do { __builtin_amdgcn_s_setprio(1); _Pragma("unroll") for (int m = 0; m < 4; ++m) _Pragma("unroll") for (int n = 0; n < 2; ++n) _Pragma("unroll") for (int k = 0; k < 2; ++k) \
        acc[ai][bj][m][n] = __builtin_amdgcn_mfma_f32_16x16x32_bf16(Bt[n][k], At[m][k], acc[ai][bj][m][n], 0, 0, 0); __builtin_amdgcn_s_setprio(0); } while (0)
#define PG8_WAIT_V(n) asm volatile("s_waitcnt vmcnt(" #n ")" ::: "memory")
#define PG8_WAIT_L(n) asm volatile("s_waitcnt lgkmcnt(" #n ")" ::: "memory")
#define PG8_BAR __builtin_amdgcn_s_barrier()
#define PG8_SCHED __builtin_amdgcn_sched_barrier(0)
    Unit cur, nxt; int ui = 0;
    if (!S.next(0, cur)) return;
    f32x4 acc[2][2][4][2];
#pragma unroll
    for (int a = 0; a < 2; ++a)
#pragma unroll
        for (int b = 0; b < 2; ++b)
#pragma unroll
            for (int m = 0; m < 4; ++m)
#pragma unroll
                for (int n = 0; n < 2; ++n) acc[a][b][m][n] = (f32x4){0.f, 0.f, 0.f, 0.f};
    bf16x8 At[4][2], B0[2][2], B1[2][2];
    const char* cA = (const char*)g.A + (size_t)cur.pm * tstepA; const char* cB = (const char*)g.Bt + (size_t)cur.pn * tstepB;
    S.a_ready(cur);
    if constexpr (SP2) {
        PG8_STAGE(PG8_SB(0, 0), cB, voffB); PG8_STAGE(PG8_SB(0, 1), cB + hstepB, voffB); PG8_STAGE(PG8_SA(0, 0), cA, voffA); PG8_STAGE(PG8_SA(0, 1), cA + hstepA, voffA);
        if (wr == 1) PG8_BAR;
        PG8_WAIT_V(2); PG8_BAR;
        PG8_STAGE(PG8_SB(1, 0), cB + kstep, voffB); PG8_STAGE(PG8_SA(1, 0), cA + kstep, voffA); PG8_STAGE(PG8_SB(1, 1), cB + hstepB + kstep, voffB);
        PG8_WAIT_V(6); PG8_BAR;
    } else {
        PG8_STAGE(PG8_SB(0, 0), cB, voffB); PG8_STAGE(PG8_SA(0, 0), cA, voffA); PG8_STAGE(PG8_SB(0, 1), cB + hstepB, voffB); PG8_STAGE(PG8_SA(0, 1), cA + hstepA, voffA);
        if (wr == 1) PG8_BAR;
        PG8_WAIT_V(4); PG8_BAR;
        PG8_STAGE(PG8_SB(1, 0), cB + kstep, voffB); PG8_STAGE(PG8_SA(1, 0), cA + kstep, voffA); PG8_STAGE(PG8_SB(1, 1), cB + hstepB + kstep, voffB);
        PG8_WAIT_V(6); PG8_BAR;
    }
    for (;;) {
        const bool has_next = S.next(ui + 1, nxt);
        const char* nA = has_next ? (const char*)g.A + (size_t)nxt.pm * tstepA : cA; const char* nB = has_next ? (const char*)g.Bt + (size_t)nxt.pn * tstepB : cB;
        for (int t = 0; t < nt; t += 2) {
            const bool last = (t == nt - 2);
            const char* a1 = cA + (size_t)(t + 1) * kstep;
            const char* a2 = last ? nA : cA + (size_t)(t + 2) * kstep; const char* b2 = last ? nB : cB + (size_t)(t + 2) * kstep;
            const char* a3 = a2 + kstep; const char* b3 = b2 + kstep;
            if (last && has_next) S.a_ready(nxt);
            if constexpr (SP2) {
            PG8_LDB(B0, 0, 0); PG8_LDB(B1, 0, 1); PG8_SCHED; PG8_LDA(At, 0, 0); PG8_STAGE(PG8_SA(1, 1), a1 + hstepA, voffA);
            PG8_WAIT_V(8); PG8_WAIT_L(0); PG8_BAR; PG8_MMA(0, 0, At, B0); PG8_MMA(0, 1, At, B1); PG8_BAR; PG8_SCHED;
            PG8_LDA(At, 0, 1); PG8_STAGE(PG8_SB(0, 0), b2, voffB); PG8_STAGE(PG8_SB(0, 1), b2 + hstepB, voffB); PG8_STAGE(PG8_SA(0, 0), a2, voffA);
            PG8_WAIT_V(8); PG8_WAIT_L(0); PG8_BAR; PG8_MMA(1, 0, At, B0); PG8_MMA(1, 1, At, B1); PG8_BAR; PG8_SCHED;
            PG8_LDB(B0, 1, 0); PG8_LDB(B1, 1, 1); PG8_SCHED; PG8_LDA(At, 1, 0); PG8_STAGE(PG8_SA(0, 1), a2 + hstepA, voffA);
            PG8_WAIT_V(8); PG8_WAIT_L(0); PG8_BAR; PG8_MMA(0, 0, At, B0); PG8_MMA(0, 1, At, B1); PG8_BAR; PG8_SCHED;
            PG8_LDA(At, 1, 1); PG8_STAGE(PG8_SB(1, 0), b3, voffB); PG8_STAGE(PG8_SB(1, 1), b3 + hstepB, voffB); PG8_STAGE(PG8_SA(1, 0), a3, voffA);
            PG8_WAIT_V(8); PG8_WAIT_L(0); PG8_BAR; PG8_MMA(1, 0, At, B0); PG8_MMA(1, 1, At, B1); PG8_BAR; PG8_SCHED;
            } else {
            PG8_LDB(B0, 0, 0); PG8_SCHED; PG8_LDA(At, 0, 0); PG8_STAGE(PG8_SA(1, 1), a1 + hstepA, voffA);
            PG8_WAIT_L(8); PG8_BAR; PG8_WAIT_L(0); PG8_MMA(0, 0, At, B0); PG8_BAR; PG8_SCHED;
            PG8_LDB(B1, 0, 1); PG8_STAGE(PG8_SB(0, 0), b2, voffB);
            PG8_BAR; PG8_WAIT_L(0); PG8_MMA(0, 1, At, B1); PG8_BAR;
            PG8_LDA(At, 0, 1); PG8_STAGE(PG8_SA(0, 0), a2, voffA);
            PG8_BAR; PG8_WAIT_L(0); PG8_MMA(1, 0, At, B0); PG8_BAR; PG8_SCHED;
            PG8_STAGE(PG8_SB(0, 1), b2 + hstepB, voffB);
            PG8_WAIT_V(6); PG8_BAR; PG8_MMA(1, 1, At, B1); PG8_BAR;
            PG8_LDB(B0, 1, 0); PG8_SCHED; PG8_LDA(At, 1, 0); PG8_STAGE(PG8_SA(0, 1), a2 + hstepA, voffA);
            PG8_WAIT_L(8); PG8_BAR; PG8_WAIT_L(0); PG8_MMA(0, 0, At, B0); PG8_BAR; PG8_SCHED;
            PG8_LDB(B1, 1, 1); PG8_STAGE(PG8_SB(1, 0), b3, voffB);
            PG8_BAR; PG8_WAIT_L(0); PG8_MMA(0, 1, At, B1); PG8_BAR;
            PG8_LDA(At, 1, 1); PG8_STAGE(PG8_SA(1, 0), a3, voffA);
            PG8_BAR; PG8_WAIT_L(0); PG8_MMA(1, 0, At, B0); PG8_BAR; PG8_SCHED;
            PG8_STAGE(PG8_SB(1, 1), b3 + hstepB, voffB);
            PG8_WAIT_V(6); PG8_BAR; PG8_MMA(1, 1, At, B1); PG8_BAR;
            }
        }
        if constexpr (ALIGN_EPI) { if (wr == 0) PG8_BAR; }
        if constexpr (!AFTER_DRAIN) { E(acc, cur, wr, wc, fr, fq); S.done(cur); }
        if (!has_next) break;
#pragma unroll
        for (int a = 0; a < 2; ++a)
#pragma unroll
            for (int b = 0; b < 2; ++b)
#pragma unroll
                for (int m = 0; m < 4; ++m)
#pragma unroll
                    for (int n = 0; n < 2; ++n) acc[a][b][m][n] = (f32x4){0.f, 0.f, 0.f, 0.f};
        cur = nxt; cA = nA; cB = nB; ++ui;
        if constexpr (ALIGN_EPI) { if (wr == 1) PG8_BAR; }
    }
    PG8_WAIT_V(0);
    if constexpr (!ALIGN_EPI) { if (wr == 0) PG8_BAR; }
    PG8_BAR;
    if constexpr (AFTER_DRAIN) { E.fused(acc, cur, wr, wc, fr, fq, lds, wid, lane); }
#undef PG8_SA
#undef PG8_SB
#undef PG8_STAGE
#undef PG8_LDA
#undef PG8_LDB
#undef PG8_MMA
#undef PG8_WAIT_V
#undef PG8_WAIT_L
#undef PG8_BAR
#undef PG8_SCHED
}
}
using pg8::Unit;

struct EpiProj {
    static constexpr bool PERM = true;
    bf16* UPERM; float* USAMP; float* V;
    __device__ __forceinline__ void operator()(const f32x4 (&acc)[2][2][4][2], const Unit& u, int wr, int wc, int fr, int fq) const {
#pragma unroll
        for (int ai = 0; ai < 2; ++ai)
#pragma unroll
            for (int m = 0; m < 4; ++m) {
                const int row = u.pm * 256 + ai * 128 + wr * 64 + m * 16 + fr;
#pragma unroll
                for (int bj = 0; bj < 2; ++bj) {
                    const int col0 = u.pn * 256 + bj * 128 + wc * 32 + fq * 8;
                    const f32x4 v0 = acc[ai][bj][m][0], v1 = acc[ai][bj][m][1];
                    if (u.pn < 2) {
                        if (u.pm < 64) {
                            const int g = col0 >> 4, h0 = col0 & 15, nb = row >> 11, tl = row & 2047, c = tl >> 4, j = tl & 15;
                            v4u w; w.x = cvt_pk_bf16(v0[0], v0[1]); w.y = cvt_pk_bf16(v0[2], v0[3]); w.z = cvt_pk_bf16(v1[0], v1[1]); w.w = cvt_pk_bf16(v1[2], v1[3]);
                            *(v4u*)(UPERM + ((size_t)(g * NROW + nb * NCH + c) * 256 + j * 16 + h0)) = w;
                        } else {
                            const int ns = row - MP;
                            if (ns < NS) { *(f32x4*)(USAMP + (size_t)ns * 512 + col0) = v0; *(f32x4*)(USAMP + (size_t)ns * 512 + col0 + 4) = v1; }
                        }
                    } else {
                        float* p = V + (size_t)row * 512 + (col0 - 512);
                        *(f32x4*)p = v0; *(f32x4*)(p + 4) = v1;
                    }
                }
            }
    }
};
struct EpiGlu {
    static constexpr bool PERM = true;
    const bf16* YG; bf16* AMIX;
    __device__ __forceinline__ void operator()(const f32x4 (&acc)[2][2][4][2], const Unit& u, int wr, int wc, int fr, int fq) const {
#pragma unroll
        for (int ai = 0; ai < 2; ++ai)
#pragma unroll
            for (int m = 0; m < 4; ++m) {
                const int row = u.pm * 256 + ai * 128 + wr * 64 + m * 16 + fr;
#pragma unroll
                for (int bj = 0; bj < 2; ++bj) {
                    const int col0 = u.pn * 256 + bj * 128 + wc * 32 + fq * 8;
                    const f32x4 v0 = acc[ai][bj][m][0], v1 = acc[ai][bj][m][1];
                    const v4u y = *(const v4u*)(YG + (size_t)row * 512 + col0);
                    float o[8];
                    o[0] = bf2f(y.x & 0xffffu) * sigmoidf_(v0[0]); o[1] = bf2f(y.x >> 16) * sigmoidf_(v0[1]);
                    o[2] = bf2f(y.y & 0xffffu) * sigmoidf_(v0[2]); o[3] = bf2f(y.y >> 16) * sigmoidf_(v0[3]);
                    o[4] = bf2f(y.z & 0xffffu) * sigmoidf_(v1[0]); o[5] = bf2f(y.z >> 16) * sigmoidf_(v1[1]);
                    o[6] = bf2f(y.w & 0xffffu) * sigmoidf_(v1[2]); o[7] = bf2f(y.w >> 16) * sigmoidf_(v1[3]);
                    v4u w; w.x = cvt_pk_bf16(o[0], o[1]); w.y = cvt_pk_bf16(o[2], o[3]); w.z = cvt_pk_bf16(o[4], o[5]); w.w = cvt_pk_bf16(o[6], o[7]);
                    *(v4u*)(AMIX + (size_t)row * D + col0) = w;
                }
                if (m == 3) asm volatile("" ::: "memory");
            }
    }
};
struct EpiOut {
    static constexpr bool PERM = true;
    const float* xp; const float* xs; float* out; bf16* XMIDB; float* SS; const bf16* XN; const float* RINV; const float* gmix;
    __device__ __forceinline__ void operator()(const f32x4 (&acc)[2][2][4][2], const Unit& u, int wr, int wc, int fr, int fq) const {
        const bool recon = (XN != nullptr) && (u.pm < 64);
        f32x4 gi[2][2];
        if (recon) {
#pragma unroll
            for (int bj = 0; bj < 2; ++bj) { const int col0 = u.pn * 256 + bj * 128 + wc * 32 + fq * 8;
#pragma unroll
                for (int n = 0; n < 2; ++n) { const f32x4 gq = *(const f32x4*)(gmix + col0 + 4 * n);
                    gi[bj][n] = (f32x4){__builtin_amdgcn_rcpf(gq[0]), __builtin_amdgcn_rcpf(gq[1]), __builtin_amdgcn_rcpf(gq[2]), __builtin_amdgcn_rcpf(gq[3])}; } }
        }
#pragma unroll
        for (int ai = 0; ai < 2; ++ai)
#pragma unroll
            for (int m = 0; m < 4; ++m) {
                const int row = u.pm * 256 + ai * 128 + wr * 64 + m * 16 + fr;
                const bool valid = row < MTOT;
                const float* xr = row < MP ? xp + (size_t)row * D : xs + (size_t)(valid ? row - MP : 0) * D;
                const float ri = recon ? RINV[row] : 0.f;
                float ss = 0.f;
#pragma unroll
                for (int bj = 0; bj < 2; ++bj) {
                    const int col0 = u.pn * 256 + bj * 128 + wc * 32 + fq * 8;
                    f32x4 x0 = (f32x4){0.f, 0.f, 0.f, 0.f}, x1 = x0;
                    if (recon) {
                        const v4u xb = *(const v4u*)(XN + (size_t)row * D + col0);
                        x0 = (f32x4){bf2f(xb.x & 0xffffu), bf2f(xb.x >> 16), bf2f(xb.y & 0xffffu), bf2f(xb.y >> 16)} * gi[bj][0] * ri;
                        x1 = (f32x4){bf2f(xb.z & 0xffffu), bf2f(xb.z >> 16), bf2f(xb.w & 0xffffu), bf2f(xb.w >> 16)} * gi[bj][1] * ri;
                    } else if (valid) { x0 = *(const f32x4*)(xr + col0); x1 = *(const f32x4*)(xr + col0 + 4); }
                    const f32x4 v0 = acc[ai][bj][m][0] + x0, v1 = acc[ai][bj][m][1] + x1;
                    ss += (v0[0] * v0[0] + v0[1] * v0[1]) + (v0[2] * v0[2] + v0[3] * v0[3]) + (v1[0] * v1[0] + v1[1] * v1[1]) + (v1[2] * v1[2] + v1[3] * v1[3]);
                    if (valid && row >= MP) { *(f32x4*)(out + (size_t)row * D + col0) = v0; *(f32x4*)(out + (size_t)row * D + col0 + 4) = v1; }
                    v4u w; w.x = cvt_pk_bf16(v0[0], v0[1]); w.y = cvt_pk_bf16(v0[2], v0[3]); w.z = cvt_pk_bf16(v1[0], v1[1]); w.w = cvt_pk_bf16(v1[2], v1[3]);
                    *(v4u*)(XMIDB + (size_t)row * D + col0) = w;
                }
                ss += __shfl_xor(ss, 16); ss += __shfl_xor(ss, 32);
                if (fq == 0) atomicAdd(SS + row, ss);
                if (m & 1) asm volatile("" ::: "memory");
            }
    }
};
struct EpiHalo {
    static constexpr bool PERM = true;
    const float* SS; float* HALO;
    __device__ __forceinline__ void operator()(const f32x4 (&acc)[2][2][4][2], const Unit& u, int wr, int wc, int fr, int fq) const {
#pragma unroll
        for (int ai = 0; ai < 2; ++ai)
#pragma unroll
            for (int m = 0; m < 4; ++m) {
                const int hr = u.pm * 256 + ai * 128 + wr * 64 + m * 16 + fr;
                const int orig = 32 * hr - 31 * (hr & 1) - 2;
                const float rs = orig >= 0 ? rsqrtf(SS[orig] * (1.0f / D) + EPS) : 0.f;
#pragma unroll
                for (int bj = 0; bj < 2; ++bj) {
                    const int col0 = u.pn * 256 + bj * 128 + wc * 32 + fq * 8;
                    float* p = HALO + (size_t)hr * FF2 + col0;
                    const f32x4 h0 = acc[ai][bj][m][0] * rs, h1 = acc[ai][bj][m][1] * rs;
                    *(f32x4*)p = h0; *(f32x4*)(p + 4) = h1;
                }
            }
    }
};
struct EpiUp {
    static constexpr bool PERM = true;
    bf16* ACT; const float* SS; const float* HALO; const float* convw; const float* convb; const float* state; float* ncp; float* ncs;
    unsigned* halo_ctr; unsigned halo_need; mutable int halo_ok;
    __device__ __forceinline__ void operator()(const f32x4 (&acc)[2][2][4][2], const Unit& u, int wr, int wc, int fr, int fq) const {
        const int lane = threadIdx.x & 63;
        if (!halo_ok) {
            if (threadIdx.x < 64) { unsigned sp = 0;
                while ((unsigned)__builtin_amdgcn_readfirstlane(__hip_atomic_load(halo_ctr, __ATOMIC_RELAXED, __HIP_MEMORY_SCOPE_AGENT)) < halo_need) { __builtin_amdgcn_s_sleep(8); if (++sp > (1u << 20)) break; }
                __builtin_amdgcn_fence(__ATOMIC_ACQUIRE, "agent"); asm volatile("s_waitcnt vmcnt(0)" ::: "memory"); }
            asm volatile("" ::: "memory"); __builtin_amdgcn_s_barrier(); asm volatile("" ::: "memory");
            halo_ok = 1;
        }
        const bool samp = (u.pm == 64);
#pragma unroll
        for (int ai = 0; ai < 2; ++ai) {
            const int rowb = u.pm * 256 + ai * 128 + wr * 64;
            const int blk = 4 * u.pm + 2 * ai + wr;
            float rs[4];
#pragma unroll
            for (int m = 0; m < 4; ++m) rs[m] = rsqrtf(SS[rowb + 16 * m + fr] * (1.0f / D) + EPS);
#pragma unroll
            for (int n = 0; n < 2; ++n) {
                f32x4 cg[4];
#pragma unroll
                for (int bj = 0; bj < 2; ++bj) {
                    const int oc = (bj ? FF : 0) + 128 * u.pn + 32 * wc + 8 * fq + 4 * n;
                    const int cgc = 256 * u.pn + 128 * bj + 32 * wc + 8 * fq + 4 * n;
                    const f32x4 cw0 = *(const f32x4*)(convw + oc), cw1 = *(const f32x4*)(convw + FF2 + oc), cw2 = *(const f32x4*)(convw + 2 * FF2 + oc), cb = *(const f32x4*)(convb + oc);
                    f32x4 v[4];
#pragma unroll
                    for (int m = 0; m < 4; ++m) v[m] = acc[ai][bj][m][n] * rs[m];
                    f32x4 hv = (f32x4){0.f, 0.f, 0.f, 0.f};
                    if (!samp) {
                        if ((blk & 31) != 0 && fr >= 14) hv = *(const f32x4*)(HALO + (size_t)(2 * blk + fr - 14) * FF2 + cgc);
                        if ((u.pm & 7) == 7 && ai == 1 && wr == 1 && fr >= 14) *(f32x4*)(ncp + (size_t)((u.pm >> 3) * 2 + (fr - 14)) * FF2 + oc) = v[3];
                    }
#pragma unroll
                    for (int m = 0; m < 4; ++m) {
                        f32x4 cv;
                        if (!samp) {
                            const f32x4 prev = m ? v[m - 1] : hv;
#pragma unroll
                            for (int e = 0; e < 4; ++e) {
                                const int vi = __float_as_int(v[m][e]), pi = __float_as_int(prev[e]);
                                const int o1 = __builtin_amdgcn_mov_dpp(pi, 0x121, 0xf, 0xf, false);
                                const int o2 = __builtin_amdgcn_mov_dpp(pi, 0x122, 0xf, 0xf, false);
                                const float p1 = __int_as_float(__builtin_amdgcn_update_dpp(o1, vi, 0x111, 0xf, 0xf, false));
                                const float p2 = __int_as_float(__builtin_amdgcn_update_dpp(o2, vi, 0x112, 0xf, 0xf, false));
                                cv[e] = cb[e] + cw0[e] * p2 + cw1[e] * p1 + cw2[e] * v[m][e];
                            }
                        } else {
                            const int ns = rowb + 16 * m + fr - MP;
                            f32x4 s0 = (f32x4){0.f, 0.f, 0.f, 0.f}, s1 = s0;
                            if (ns < NS) {
                                s0 = *(const f32x4*)(state + (size_t)(ns * 2 + 0) * FF2 + oc); s1 = *(const f32x4*)(state + (size_t)(ns * 2 + 1) * FF2 + oc);
                                *(f32x4*)(ncs + (size_t)(ns * 2 + 0) * FF2 + oc) = s1; *(f32x4*)(ncs + (size_t)(ns * 2 + 1) * FF2 + oc) = v[m];
                            }
                            cv = cb + cw0 * s0 + cw1 * s1 + cw2 * v[m];
                        }
                        if (bj == 0) cg[m] = gelu4(cv);
                        else {
                            const f32x4 r = cg[m] * cv;
                            v2u w; w.x = cvt_pk_bf16(r[0], r[1]); w.y = cvt_pk_bf16(r[2], r[3]);
                            *(v2u*)(ACT + (size_t)(rowb + 16 * m + fr) * FF + 128 * u.pn + 32 * wc + 8 * fq + 4 * n) = w;
                        }
                    }
                    asm volatile("" ::: "memory");
                }
            }
        }
    }
};
template <bool ATOMIC> struct EpiDown {
    static constexpr bool PERM = true;
    float* out;
    __device__ __forceinline__ void operator()(const f32x4 (&acc)[2][2][4][2], const Unit& u, int wr, int wc, int fr, int fq) const {
#pragma unroll
        for (int ai = 0; ai < 2; ++ai)
#pragma unroll
            for (int m = 0; m < 4; ++m) {
                const int row = u.pm * 256 + ai * 128 + wr * 64 + m * 16 + fr;
                if (row < MTOT) {
#pragma unroll
                    for (int bj = 0; bj < 2; ++bj) {
                        const int col0 = u.pn * 256 + bj * 128 + wc * 32 + fq * 8;
                        float* p = out + (size_t)row * D + col0;
                        if (ATOMIC) {
#pragma unroll
                            for (int e = 0; e < 4; ++e) { atomicAdd(p + e, acc[ai][bj][m][0][e]); atomicAdd(p + 4 + e, acc[ai][bj][m][1][e]); }
                        } else {
                            const f32x4 x0 = *(const f32x4*)p, x1 = *(const f32x4*)(p + 4);
                            *(f32x4*)p = x0 + acc[ai][bj][m][0]; *(f32x4*)(p + 4) = x1 + acc[ai][bj][m][1];
                        }
                    }
                }
                asm volatile("" ::: "memory");
            }
    }
};


struct EpiDownNorm {
    static constexpr bool PERM = true;
    const bf16* XMIDB; const float* gfin; float* out; float* xslot; unsigned* cnt;
    __device__ __forceinline__ void fused(f32x4 (&acc)[2][2][4][2], const Unit& u, int wr, int wc, int fr, int fq, LAS unsigned char* lds, int wid, int lane) const {
        LAS float* P = (LAS float*)lds;
        LAS float* S = (LAS float*)(lds + 4096);
#pragma unroll
        for (int ai = 0; ai < 2; ++ai)
#pragma unroll
            for (int m = 0; m < 4; ++m) {
                const int r = ai * 128 + wr * 64 + m * 16 + fr; const size_t row = (size_t)u.pm * 256 + r;
                float ss = 0.f;
#pragma unroll
                for (int bj = 0; bj < 2; ++bj) {
                    const int col0 = u.pn * 256 + bj * 128 + wc * 32 + fq * 8;
                    const v4u xb = *(const v4u*)(XMIDB + row * D + col0);
                    f32x4 v0 = acc[ai][bj][m][0], v1 = acc[ai][bj][m][1];
                    v0[0] += bf2f(xb.x & 0xffffu); v0[1] += bf2f(xb.x >> 16); v0[2] += bf2f(xb.y & 0xffffu); v0[3] += bf2f(xb.y >> 16);
                    v1[0] += bf2f(xb.z & 0xffffu); v1[1] += bf2f(xb.z >> 16); v1[2] += bf2f(xb.w & 0xffffu); v1[3] += bf2f(xb.w >> 16);
                    acc[ai][bj][m][0] = v0; acc[ai][bj][m][1] = v1;
                    ss += (v0[0] * v0[0] + v0[1] * v0[1]) + (v0[2] * v0[2] + v0[3] * v0[3]) + (v1[0] * v1[0] + v1[1] * v1[1]) + (v1[2] * v1[2] + v1[3] * v1[3]);
                }
                ss += __shfl_xor(ss, 16); ss += __shfl_xor(ss, 32);
                if (fq == 0) P[r * 4 + wc] = ss;
                if (m == 3) asm volatile("" ::: "memory");
            }
        __syncthreads();
        const int row = wid * 32 + (lane & 31);
        if (lane < 32) {
            const float t = (P[row * 4 + 0] + P[row * 4 + 1]) + (P[row * 4 + 2] + P[row * 4 + 3]);
            __hip_atomic_store(xslot + ((size_t)(u.pm * 256 + row) * 4 + u.pn), t, __ATOMIC_RELAXED, __HIP_MEMORY_SCOPE_AGENT);
        }
        asm volatile("s_waitcnt vmcnt(0)" ::: "memory");
        if (lane == 0) __hip_atomic_fetch_add(cnt + 64 * u.pm, 1u, __ATOMIC_RELAXED, __HIP_MEMORY_SCOPE_AGENT);
        if (wid == 0) {
            unsigned sp = 0;
            while ((unsigned)__builtin_amdgcn_readfirstlane(__hip_atomic_load(cnt + 64 * u.pm, __ATOMIC_RELAXED, __HIP_MEMORY_SCOPE_AGENT)) < 32u) { __builtin_amdgcn_s_sleep(2); if (++sp > (1u << 20)) break; }
            __builtin_amdgcn_fence(__ATOMIC_ACQUIRE, "agent");
        }
        asm volatile("s_waitcnt vmcnt(0) lgkmcnt(0)" ::: "memory");
        __syncthreads();
        if (lane < 32) {
            const float* sl = xslot + (size_t)(u.pm * 256 + row) * 4; float t = 0.f;
#pragma unroll
            for (int q = 0; q < 4; ++q) t += __hip_atomic_load(sl + q, __ATOMIC_RELAXED, __HIP_MEMORY_SCOPE_AGENT);
            S[row] = rsqrtf(t * (1.0f / D) + EPS);
        }
        __syncthreads();
        f32x4 gv[2][2];
#pragma unroll
        for (int bj = 0; bj < 2; ++bj) { const int col0 = u.pn * 256 + bj * 128 + wc * 32 + fq * 8; gv[bj][0] = *(const f32x4*)(gfin + col0); gv[bj][1] = *(const f32x4*)(gfin + col0 + 4); }
#pragma unroll
        for (int ai = 0; ai < 2; ++ai)
#pragma unroll
            for (int m = 0; m < 4; ++m) {
                const int r = ai * 128 + wr * 64 + m * 16 + fr; const size_t row2 = (size_t)u.pm * 256 + r; const float rs = S[r];
#pragma unroll
                for (int bj = 0; bj < 2; ++bj) {
                    const int col0 = u.pn * 256 + bj * 128 + wc * 32 + fq * 8;
                    *(f32x4*)(out + row2 * D + col0) = acc[ai][bj][m][0] * rs * gv[bj][0]; *(f32x4*)(out + row2 * D + col0 + 4) = acc[ai][bj][m][1] * rs * gv[bj][1];
                }
            }
    }
};

#define XB_TMO      128
#define XB_XCNT(j)  (256  + 64 * (j))
#define XB_XSUB(j)  (1280 + 64 * (j))
#define XB_XGEN(j)  (2304 + 64 * (j))
#define XB_TOP      3328
#define XB_TOPGEN   3392
#define XCD_BAR_WORDS 3456
#define XB_SPIN_CAP (1u << 18)

__device__ __forceinline__ unsigned xb_ld(unsigned* p)              { return __hip_atomic_load(p, __ATOMIC_RELAXED, __HIP_MEMORY_SCOPE_AGENT); }
__device__ __forceinline__ unsigned xb_add(unsigned* p, unsigned v) { return __hip_atomic_fetch_add(p, v, __ATOMIC_RELAXED, __HIP_MEMORY_SCOPE_AGENT); }
__device__ __forceinline__ unsigned xb_xcc_id() { return (unsigned)__builtin_amdgcn_s_getreg((3 << 11) | 20) & 0xFu; }
#define XB_SPIN(cond, bar) do { unsigned _sp = 0; while (cond) { __builtin_amdgcn_s_sleep(1); \
    if ((++_sp & 255u) == 0u) { if (xb_ld(&(bar)[XB_TMO])) break; if (_sp > XB_SPIN_CAP) { atomicAdd(&(bar)[XB_TMO], 1u); break; } } } } while (0)

struct XcdBarrier {
    unsigned* bar; unsigned x;
    volatile LAS unsigned* st;
};

__device__ __forceinline__ XcdBarrier xcd_barrier_post(unsigned* bar, volatile LAS unsigned* st) {
    XcdBarrier b; b.bar = bar; b.x = xb_xcc_id(); b.st = st;
    if (threadIdx.x == 0) (void)xb_add(&bar[XB_XCNT(b.x)], 1u);
    return b;
}
__device__ __forceinline__ void xcd_barrier_complete(unsigned* bar, unsigned x, unsigned& nloc, unsigned& nx) {
    const unsigned G = gridDim.x * gridDim.y * gridDim.z;
    unsigned sum, cnt, mine, sp = 0u;
    for (;;) {
        sum = 0u; cnt = 0u; mine = 0u;
#pragma unroll
        for (unsigned j = 0; j < 16; ++j) { const unsigned c = xb_ld(&bar[XB_XCNT(j)]); sum += c; cnt += (c > 0u) ? 1u : 0u; mine = (j == x) ? c : mine; }
        if (sum == G) break;
        __builtin_amdgcn_s_sleep(1);
        if ((++sp & 255u) == 0u) { if (xb_ld(&bar[XB_TMO])) break; if (sp > XB_SPIN_CAP) { atomicAdd(&bar[XB_TMO], 1u); break; } }
    }
    nloc = mine > 0u ? mine : 1u; nx = cnt > 0u ? cnt : 1u;
}

__device__ __forceinline__ void xcd_barrier(const XcdBarrier& b) {
    asm volatile("s_waitcnt vmcnt(0)" ::: "memory");
    __syncthreads();
    if (threadIdx.x == 0) {
        unsigned* bar = b.bar;
        __builtin_amdgcn_s_waitcnt(0);
        unsigned nloc = b.st[0], nx = b.st[1];
        if (nloc == 0u) { xcd_barrier_complete(bar, b.x, nloc, nx); b.st[0] = nloc; b.st[1] = nx; }
        const unsigned old = xb_add(&bar[XB_XSUB(b.x)], 1u);
        const unsigned gen = old / nloc;
        if (old + 1u == (gen + 1u) * nloc) {
            __builtin_amdgcn_fence(__ATOMIC_RELEASE, "agent");
            asm volatile("s_waitcnt vmcnt(0)" ::: "memory");
            const unsigned og = xb_add(&bar[XB_TOP], 1u);
            const unsigned tg = og / nx;
            if (og + 1u == (tg + 1u) * nx) xb_add(&bar[XB_TOPGEN], 1u);
            else XB_SPIN(xb_ld(&bar[XB_TOPGEN]) == tg, bar);
            __builtin_amdgcn_fence(__ATOMIC_ACQUIRE, "agent");
            xb_add(&bar[XB_XGEN(b.x)], 1u);
            asm volatile("s_waitcnt vmcnt(0)" ::: "memory");
        } else {
            XB_SPIN(xb_ld(&bar[XB_XGEN(b.x)]) == gen, bar);
            __builtin_amdgcn_fence(__ATOMIC_ACQUIRE, "agent");
            asm volatile("s_waitcnt vmcnt(0)" ::: "memory");
        }
    }
    __syncthreads();
}


struct DepOrder : pg8::StaticOrder {
    unsigned* wait_ctr; unsigned wait_need; int wait_pm; unsigned* done_ctr; int done_pm;
    bool done_rel = true;
    int rot = 0;
    __device__ __forceinline__ bool next(int i, Unit& u) const {
        const int span = lim - L_off, n_c = span / G + (c < span % G ? 1 : 0); if (i >= n_c) return false;
        return pg8::StaticOrder::next(rot ? (i + rot) % n_c : i, u);
    }
    __device__ __forceinline__ void a_ready(const Unit& u) const {
        if (wait_pm == -2 || (wait_pm >= 0 && u.pm != wait_pm)) return;
        if (threadIdx.x < 64) {
            unsigned sp = 0;
            while ((unsigned)__builtin_amdgcn_readfirstlane(__hip_atomic_load(wait_ctr, __ATOMIC_RELAXED, __HIP_MEMORY_SCOPE_AGENT)) < wait_need) { __builtin_amdgcn_s_sleep(2); if (++sp > (1u << 21)) break; }
            __builtin_amdgcn_fence(__ATOMIC_ACQUIRE, "agent");
            asm volatile("s_waitcnt vmcnt(0)" ::: "memory");
        }
        asm volatile("" ::: "memory"); __builtin_amdgcn_s_barrier(); asm volatile("" ::: "memory");
    }
    __device__ __forceinline__ void done(const Unit& u) const {
        if (done_pm == -2 || (done_pm >= 0 && u.pm != done_pm)) return;
        asm volatile("s_waitcnt vmcnt(0)" ::: "memory");
        asm volatile("" ::: "memory"); __builtin_amdgcn_s_barrier(); asm volatile("" ::: "memory");
        if (threadIdx.x < 64) {
            if (done_rel) { __builtin_amdgcn_fence(__ATOMIC_RELEASE, "agent"); asm volatile("s_waitcnt vmcnt(0)" ::: "memory"); }
            if (threadIdx.x == 0) __hip_atomic_fetch_add(done_ctr, 1u, __ATOMIC_RELAXED, __HIP_MEMORY_SCOPE_AGENT);
        }
    }
};

struct Args { const float* in[26]; float* out; unsigned char* ws; };

typedef const __attribute__((address_space(4))) Args* KArgs;
__device__ __forceinline__ KArgs kargs() { KArgs p = (KArgs)__builtin_amdgcn_kernarg_segment_ptr(); asm volatile("" : "+s"(p)); return p; }
#define KIN(i) ((const float*)k->in[i])
#define WSP(T, off) ((T*)(k->ws + (off)))
__device__ __forceinline__ f32x2 cmul(f32x2 a, f32x2 b) { return (f32x2){a.x * b.x - a.y * b.y, a.x * b.y + a.y * b.x}; }
__device__ __forceinline__ f32x2 cexp_(float re, float im) { float s, c; sincosf(im, &s, &c); const float e = expf(re); return (f32x2){e * c, e * s}; }
__device__ __forceinline__ f32x2 zoh_coef(float are, float aim, float dt) {
    const f32x2 ab = cexp_(dt * are, dt * aim); const float nr = ab.x - 1.0f, ni = ab.y, den = 1.0f / (are * are + aim * aim);
    return (f32x2){(nr * are + ni * aim) * den, (ni * are - nr * aim) * den};
}

__device__ __forceinline__ void transpose_item(const float* W, int N, bf16* WT, int ldt, int k0, int n0, int src_n0, const float* gk, LAS float* scr, int lane) {
    float wv[32];
#pragma unroll
    for (int i = 0; i < 32; ++i) { const int kk = 2 * i + (lane >> 5); wv[i] = W[(size_t)(k0 + kk) * N + src_n0 + (lane & 31)]; }
    if (gk) {
#pragma unroll
        for (int i = 0; i < 32; ++i) wv[i] *= gk[k0 + 2 * i + (lane >> 5)];
    }
#pragma unroll
    for (int i = 0; i < 32; ++i) scr[(2 * i + (lane >> 5)) * 33 + (lane & 31)] = wv[i];
    LDS_WAIT(); asm volatile("" ::: "memory");
    const int c = lane & 7;
#pragma unroll
    for (int j = 0; j < 4; ++j) { const int n = (lane >> 3) + 8 * j; const LAS float* s = scr + (8 * c) * 33 + n;
        v4u o; o.x = cvt_pk_bf16(s[0 * 33], s[1 * 33]); o.y = cvt_pk_bf16(s[2 * 33], s[3 * 33]); o.z = cvt_pk_bf16(s[4 * 33], s[5 * 33]); o.w = cvt_pk_bf16(s[6 * 33], s[7 * 33]);
        *(v4u*)(WT + (size_t)(n0 + n) * ldt + k0 + 8 * c) = o; }
    LDS_WAIT(); asm volatile("" ::: "memory");
}

__global__ void __launch_bounds__(512, 2) fwd_kernel(Args a) {
    extern __shared__ __attribute__((aligned(16))) unsigned char lds_raw[];
    LAS unsigned char* lds = (LAS unsigned char*)lds_raw;
    cg::grid_group grid = cg::this_grid();
    const int tid = threadIdx.x, lane = tid & 63, wave = __builtin_amdgcn_readfirstlane(tid >> 6);
    const int G = gridDim.x, bx = blockIdx.x;
    const int gw = bx * 8 + wave, NGW = G * 8;
    const size_t gt = (size_t)bx * 512 + tid, NGT = (size_t)G * 512;
    volatile LAS unsigned* MISC = (volatile LAS unsigned*)(lds + 131072 + 1024);
    if (tid < 16) MISC[tid] = 0u;
    __syncthreads();
    XcdBarrier xbar;
    { KArgs k = kargs(); if (k->ws == nullptr) grid.sync();
      xbar = xcd_barrier_post((unsigned*)(k->ws + WS_BAR), MISC + 8); }

    {
        KArgs k = kargs();
        const float* x_p = KIN(0); const float* x_s = KIN(1); const float* g_mix = KIN(6); const float* w_in = KIN(7); const float* a_re = KIN(8); const float* a_im = KIN(9); const float* log_dt = KIN(10);
        const float* b_re = KIN(11); const float* b_im = KIN(12); const float* w_glu = KIN(16);
        bf16* WIN = WSP(bf16, WS_WIN); bf16* WGLU = WSP(bf16, WS_WGLU); unsigned* CTR = WSP(unsigned, WS_CTR);
        f32x2* ABAR = WSP(f32x2, WS_ABAR); f32x2* AT = WSP(f32x2, WS_AT); f32x2* BBAR = WSP(f32x2, WS_BBAR); f32x2* APW = WSP(f32x2, WS_APW);
        float* SS = WSP(float, WS_SS); bf16* XN = WSP(bf16, WS_XN); float* RINV = WSP(float, WS_RINV);
        {
            LAS float* scr = (LAS float*)(lds + wave * 16384);
            constexpr int I_IN = 16 * 32, I_GLU = 8 * 16;
            for (int it = gw; it < I_IN + I_GLU; it += NGW) {
                int r = it;
                if (r < I_IN) { const int kb = r / 32, nb = r % 32; transpose_item(w_in, D, WIN, D, 64 * kb, 32 * nb, 32 * nb, nullptr, scr, lane); continue; } r -= I_IN;
                { const int kb = r / 16, nb = r % 16; transpose_item(w_glu, 512, WGLU, 512, 64 * kb, 32 * nb, 32 * nb, nullptr, scr, lane); }
            }
        }
        auto xn_rows2 = [&](int m) {
            v2u* o8 = (v2u*)(XN + (size_t)m * D) + lane;
            if (m < MTOT) {
                const float* xr = m < MP ? x_p + (size_t)m * D : x_s + (size_t)(m - MP) * D;
                const f32x4* xr4 = (const f32x4*)xr + lane;
                f32x4 v[2][4]; float sq0 = 0.f, sq1 = 0.f;
#pragma unroll
                for (int j = 0; j < 4; ++j) { v[0][j] = xr4[64 * j]; v[1][j] = xr4[256 + 64 * j]; }
#pragma unroll
                for (int j = 0; j < 4; ++j) { sq0 += (v[0][j][0] * v[0][j][0] + v[0][j][1] * v[0][j][1]) + (v[0][j][2] * v[0][j][2] + v[0][j][3] * v[0][j][3]);
                                              sq1 += (v[1][j][0] * v[1][j][0] + v[1][j][1] * v[1][j][1]) + (v[1][j][2] * v[1][j][2] + v[1][j][3] * v[1][j][3]); }
                const float ms0 = wave_sum(sq0) * (1.0f / D) + EPS, ms1 = wave_sum(sq1) * (1.0f / D) + EPS; const float rs0 = rsqrtf(ms0), rs1 = rsqrtf(ms1);
                if (lane == 0) { RINV[m] = sqrtf(ms0); RINV[m + 1] = sqrtf(ms1); }
#pragma unroll
                for (int j = 0; j < 4; ++j) { const f32x4 gq = ((const f32x4*)g_mix)[lane + 64 * j]; const f32x4 y0 = v[0][j] * rs0 * gq, y1 = v[1][j] * rs1 * gq;
                    v2u w; w.x = cvt_pk_bf16(y0[0], y0[1]); w.y = cvt_pk_bf16(y0[2], y0[3]); o8[64 * j] = w;
                    v2u w1; w1.x = cvt_pk_bf16(y1[0], y1[1]); w1.y = cvt_pk_bf16(y1[2], y1[3]); o8[256 + 64 * j] = w1; }
            } else {
#pragma unroll
                for (int j = 0; j < 4; ++j) { o8[64 * j] = (v2u){0u, 0u}; o8[256 + 64 * j] = (v2u){0u, 0u}; }
            }
        };
        auto xn_row1 = [&](int m) {
            v2u* o8 = (v2u*)(XN + (size_t)m * D) + lane;
            if (m < MTOT) {
                const float* xr = m < MP ? x_p + (size_t)m * D : x_s + (size_t)(m - MP) * D;
                const f32x4* xr4 = (const f32x4*)xr + lane;
                f32x4 v[4]; float sq = 0.f;
#pragma unroll
                for (int j = 0; j < 4; ++j) v[j] = xr4[64 * j];
#pragma unroll
                for (int j = 0; j < 4; ++j) sq += (v[j][0] * v[j][0] + v[j][1] * v[j][1]) + (v[j][2] * v[j][2] + v[j][3] * v[j][3]);
                const float ms = wave_sum(sq) * (1.0f / D) + EPS; const float rs = rsqrtf(ms);
                if (lane == 0) RINV[m] = sqrtf(ms);
#pragma unroll
                for (int j = 0; j < 4; ++j) { const f32x4 gq = ((const f32x4*)g_mix)[lane + 64 * j]; const f32x4 y = v[j] * rs * gq;
                    v2u w; w.x = cvt_pk_bf16(y[0], y[1]); w.y = cvt_pk_bf16(y[2], y[3]); o8[64 * j] = w; }
            } else {
#pragma unroll
                for (int j = 0; j < 4; ++j) o8[64 * j] = (v2u){0u, 0u};
            }
        };
        {
            for (size_t i = gt; i < (size_t)MPAD; i += NGT) SS[i] = 0.f;
            for (int it = bx; it * 8 < NG * NP; it += G) if (tid < 8) {
                const size_t i = (size_t)it * 8 + tid;
                const int g = (int)i / NP; const float dt = expf(log_dt[g]); const float are = a_re[i], aim = a_im[i];
                f32x4 br[4], bi[4];
#pragma unroll
                for (int q = 0; q < 4; ++q) { br[q] = *(const f32x4*)(b_re + i * NH + 4 * q); bi[q] = *(const f32x4*)(b_im + i * NH + 4 * q); }
                const f32x2 ab = cexp_(dt * are, dt * aim); f32x2 pw = (f32x2){1.f, 0.f};
#pragma unroll
                for (int q = 0; q <= 16; ++q) { APW[i * 17 + q] = pw; if (q == 16) AT[i] = pw; pw = cmul(pw, ab); }
                ABAR[i] = ab;
                const float nr = ab.x - 1.0f, ni = ab.y, den = 1.0f / (are * are + aim * aim);
                const f32x2 cf = (f32x2){(nr * are + ni * aim) * den, (ni * are - nr * aim) * den};
#pragma unroll
                for (int h = 0; h < NH; ++h) BBAR[i * NH + h] = cmul(cf, (f32x2){br[h >> 2][h & 3], bi[h >> 2][h & 3]});
            }
            for (int m = 2 * gw; m < MP; m += 2 * NGW) xn_rows2(m);
            if (wave == 7) for (int m = MP + bx; m < MPAD; m += G) xn_row1(m);
        }
    }
    xcd_barrier(xbar);

    {
        KArgs k = kargs();
        bf16* XN = WSP(bf16, WS_XN); bf16* WIN = WSP(bf16, WS_WIN); bf16* UPERM = WSP(bf16, WS_UPERM); float* USAMP = WSP(float, WS_USAMP); float* V = WSP(float, WS_V);
        pg8::Gemm g{XN, WIN, MP, D, D, D}; pg8::StaticOrder S; S.init(MP, D, G, bx);
        EpiProj Ep{UPERM, USAMP, V};
        pg8::gemm_phase<EpiProj, pg8::StaticOrder, true, true, 0>(lds, g, S, Ep);
    }
    if (bx < 64) {
        KArgs k = kargs();
        const bf16* XN = WSP(bf16, WS_XN); const bf16* WIN = WSP(bf16, WS_WIN); float* USAMP = WSP(float, WS_USAMP); float* V = WSP(float, WS_V);
        const int r16 = lane & 15, q4 = lane >> 4;
        f32x4 pa[8];
#pragma unroll
        for (int rbk = 0; rbk < 8; ++rbk) pa[rbk] = (f32x4){0.f, 0.f, 0.f, 0.f};
        const bf16* wp = WIN + ((size_t)(16 * bx + r16) * D + 128 * wave + 8 * q4);
        const bf16* ap = XN + ((size_t)(MP + r16) * D + 128 * wave + 8 * q4);
#pragma unroll
        for (int ks = 0; ks < 4; ++ks) {
            const bf16x8 wf = *(const bf16x8*)(wp + 32 * ks);
#pragma unroll
            for (int rbk = 0; rbk < 8; ++rbk) { const bf16x8 af = *(const bf16x8*)(ap + (size_t)rbk * 16 * D + 32 * ks); pa[rbk] = __builtin_amdgcn_mfma_f32_16x16x32_bf16(wf, af, pa[rbk], 0, 0, 0); }
        }
        LAS f32x4* red = (LAS f32x4*)lds;
#pragma unroll
        for (int rbk = 0; rbk < 8; ++rbk) red[(wave * 8 + rbk) * 64 + lane] = pa[rbk];
        __syncthreads();
        f32x4 t = (f32x4){0.f, 0.f, 0.f, 0.f};
#pragma unroll
        for (int w2 = 0; w2 < 8; ++w2) t += red[(w2 * 8 + wave) * 64 + lane];
        const int ns = 16 * wave + r16, col = 16 * bx + 4 * q4;
        if (col < 512) *(f32x4*)(USAMP + (size_t)ns * 512 + col) = t; else *(f32x4*)(V + (size_t)(MP + ns) * 512 + (col - 512)) = t;
        __syncthreads();
    } else
    {
        KArgs k = kargs();
        const float* c_re = KIN(13); const float* c_im = KIN(14); const float* s5_d = KIN(15);
        bf16* KTAB = WSP(bf16, WS_KTAB); bf16* W2 = WSP(bf16, WS_W2); bf16* W3 = WSP(bf16, WS_W3); const f32x2* BBAR = WSP(f32x2, WS_BBAR); const f32x2* APW = WSP(f32x2, WS_APW);
        const size_t vt = (size_t)(bx - 64) * 512 + tid, VNT = (size_t)(G - 64) * 512;
        for (size_t i = vt; i < (size_t)NG * 16 * 64; i += VNT) {
            const int hq = (int)i & 3, h = ((int)i >> 2) & 15, lag = ((int)i >> 6) & 15, g = (int)i >> 10;
            float s0 = 0.f, s1 = 0.f, s2 = 0.f, s3 = 0.f;
            const float* crp = c_re + (size_t)(g * NH + h) * NP; const float* cip = c_im + (size_t)(g * NH + h) * NP;
#pragma unroll 8
            for (int p = 0; p < NP; ++p) {
                const int gp = g * NP + p;
                const f32x2 ac = cmul(APW[gp * 17 + lag], (f32x2){crp[p], cip[p]});
                const f32x4 b01 = *(const f32x4*)(BBAR + (size_t)gp * NH + 4 * hq), b23 = *(const f32x4*)(BBAR + (size_t)gp * NH + 4 * hq + 2);
                s0 += ac.x * b01[0] - ac.y * b01[1]; s1 += ac.x * b01[2] - ac.y * b01[3]; s2 += ac.x * b23[0] - ac.y * b23[1]; s3 += ac.x * b23[2] - ac.y * b23[3];
            }
            if (lag == 0 && (h >> 2) == hq) { const float dd = s5_d[g * NH + h]; if ((h & 3) == 0) s0 += dd; else if ((h & 3) == 1) s1 += dd; else if ((h & 3) == 2) s2 += dd; else s3 += dd; }
            v2u w; w.x = cvt_pk_bf16(s0, s1); w.y = cvt_pk_bf16(s2, s3);
            *(v2u*)(KTAB + i * 4) = w;
        }
        for (size_t i = vt; i < (size_t)NG * NP * 16; i += VNT) {
            const int j = (int)i & 15, p = ((int)i >> 4) & 63, g = (int)i >> 10; const int gp = g * NP + p;
            const f32x2 cf = APW[gp * 17 + 15 - j];
            unsigned wre[8], wim[8];
#pragma unroll
            for (int h = 0; h < NH; h += 2) {
                const f32x4 b2 = *(const f32x4*)(BBAR + (size_t)gp * NH + h);
                const f32x2 v0 = cmul(cf, (f32x2){b2[0], b2[1]}), v1 = cmul(cf, (f32x2){b2[2], b2[3]});
                wre[h >> 1] = cvt_pk_bf16(v0.x, v1.x); wim[h >> 1] = cvt_pk_bf16(v0.y, v1.y);
            }
            bf16* w2r = W2 + ((size_t)(g * 128 + 2 * p) * 256 + j * 16);
            *(v4u*)(w2r) = (v4u){wre[0], wre[1], wre[2], wre[3]}; *(v4u*)(w2r + 8) = (v4u){wre[4], wre[5], wre[6], wre[7]};
            *(v4u*)(w2r + 256) = (v4u){wim[0], wim[1], wim[2], wim[3]}; *(v4u*)(w2r + 264) = (v4u){wim[4], wim[5], wim[6], wim[7]};
        }
        for (size_t i = vt; i < (size_t)NG * 16 * 16 * 16; i += VNT) {
            const int pq = (int)i & 15, h = ((int)i >> 4) & 15, j = ((int)i >> 8) & 15, g = (int)i >> 12;
            const f32x4 cr4 = *(const f32x4*)(c_re + (size_t)(g * NH + h) * NP + 4 * pq), ci4 = *(const f32x4*)(c_im + (size_t)(g * NH + h) * NP + 4 * pq);
            unsigned w[4];
#pragma unroll
            for (int q = 0; q < 4; ++q) { const f32x2 v = cmul(APW[(g * NP + 4 * pq + q) * 17 + j + 1], (f32x2){cr4[q], ci4[q]}); w[q] = cvt_pk_bf16(v.x, -v.y); }
            *(v4u*)(W3 + ((size_t)(g * 256 + j * 16 + h) * 128 + 8 * pq)) = (v4u){w[0], w[1], w[2], w[3]};
        }
    }
    xcd_barrier(xbar);

    {
        KArgs k = kargs();
        float* out = k->out;
        const bf16* UPERM = WSP(bf16, WS_UPERM); const bf16* W2 = WSP(bf16, WS_W2); const bf16* KTAB = WSP(bf16, WS_KTAB); const bf16* W3 = WSP(bf16, WS_W3); bf16* YG = WSP(bf16, WS_YG);
        const f32x2* AT = WSP(f32x2, WS_AT);
        const int r16 = lane & 15, q4 = lane >> 4;
        LAS unsigned char* EbB = lds;
        LAS unsigned char* W2S = lds + 65536;
        LAS unsigned char* W3S = lds;
        LAS bf16* hl = (LAS bf16*)(lds + 69632 + wave * 4352);
        LAS bf16* ktl = (LAS bf16*)(lds + 133120);
        for (int task = bx; task < NG * NB; task += G) {
            const int g = task >> 3, nb = task & 7, rb = nb * 8 + wave, c0 = 16 * wave;
            const bf16* up = UPERM + ((size_t)(g * NROW + rb * 16 + r16) * 256 + 8 * q4);
            *(LAS v4u*)(ktl + tid * 8) = *(const v4u*)(KTAB + (size_t)g * 4096 + tid * 8);
            {
                const bf16* w2g = W2 + (size_t)g * 128 * 256;
                v4u tv[8];
#pragma unroll
                for (int ii = 0; ii < 8; ++ii) tv[ii] = *(const v4u*)(w2g + (size_t)(tid + 512 * ii) * 8);
#pragma unroll
                for (int ii = 0; ii < 8; ++ii) { const int idx = tid + 512 * ii, q = idx >> 5, c16 = idx & 31; *(LAS v4u*)(W2S + q * 512 + ((c16 ^ (q & 15)) << 4)) = tv[ii]; }
            }
            __syncthreads();
            {
                f32x4 ea[8];
#pragma unroll
                for (int cb = 0; cb < 8; ++cb) ea[cb] = (f32x4){0.f, 0.f, 0.f, 0.f};
                bf16x8 ufr[8];
#pragma unroll
                for (int ks = 0; ks < 8; ++ks) ufr[ks] = *(const bf16x8*)(up + 32 * ks);
#pragma unroll
                for (int ks = 0; ks < 8; ++ks)
#pragma unroll
                    for (int cb = 0; cb < 8; ++cb) { const bf16x8 wf = *(const LAS bf16x8*)(W2S + (cb * 16 + r16) * 512 + (((4 * ks + q4) ^ r16) << 4)); ea[cb] = __builtin_amdgcn_mfma_f32_16x16x32_bf16(wf, ufr[ks], ea[cb], 0, 0, 0); }
#pragma unroll
                for (int cb = 0; cb < 8; ++cb) *(LAS f32x4*)(EbB + (c0 + r16) * 512 + (((4 * cb + q4) ^ r16) << 4)) = ea[cb];
            }
            __syncthreads();
            {
                const f32x2 aT = AT[g * NP + lane]; f32x2 S = (f32x2){0.f, 0.f};
                const int ch = lane >> 1, wo = (lane & 1) * 8;
                for (int c = 0; c < c0; c += 16) {
                    f32x2 ev[16];
#pragma unroll
                    for (int q = 0; q < 16; ++q) ev[q] = *(const LAS f32x2*)(EbB + (c + q) * 512 + ((ch ^ q) << 4) + wo);
#pragma unroll
                    for (int q = 0; q < 16; ++q) S = cmul(aT, S) + ev[q];
                }
#pragma unroll
                for (int cc = 0; cc < 16; ++cc) {
                    *(LAS unsigned*)(hl + cc * 136 + 2 * lane) = cvt_pk_bf16(S.x, S.y);
                    const f32x2 e = *(const LAS f32x2*)(EbB + (c0 + cc) * 512 + ((ch ^ cc) << 4) + wo); S = cmul(aT, S) + e;
                }
                if (wave == 7) { out[O_PRE + (size_t)nb * 2048 + g * NP + lane] = S.x; out[O_PIM + (size_t)nb * 2048 + g * NP + lane] = S.y; }
            }
            __syncthreads();
            {
                const bf16* w3g = W3 + (size_t)g * 256 * 128;
                v4u tv[8];
#pragma unroll
                for (int ii = 0; ii < 8; ++ii) tv[ii] = *(const v4u*)(w3g + (size_t)(tid + 512 * ii) * 8);
#pragma unroll
                for (int ii = 0; ii < 8; ++ii) { const int idx = tid + 512 * ii, jr = idx >> 4, c16 = idx & 15; *(LAS v4u*)(W3S + jr * 256 + ((c16 ^ (jr & 15)) << 4)) = tv[ii]; }
            }
            f32x4 acc[16];
#pragma unroll
            for (int cb = 0; cb < 16; ++cb) acc[cb] = (f32x4){0.f, 0.f, 0.f, 0.f};
            const LAS bf16* kt2 = ktl + (r16 * 16 + 8 * (q4 & 1)) - (q4 >> 1) * 256;
#pragma unroll
            for (int kr = 0; kr < 4; ++kr) {
                bf16x8 ufr[2], wfr[2][16];
#pragma unroll
                for (int kk = 0; kk < 2; ++kk) { const int ks = 2 * kr + kk; ufr[kk] = *(const bf16x8*)(up + 32 * ks);
#pragma unroll
                    for (int cb = 0; cb < 16; ++cb) if (2 * ks <= cb) {
                        wfr[kk][cb] = *(const LAS bf16x8*)(kt2 + (cb - 2 * ks) * 256);
                        if (cb == 2 * ks && (q4 >> 1)) wfr[kk][cb] = (bf16x8){0, 0, 0, 0, 0, 0, 0, 0};
                    } }
#pragma unroll
                for (int kk = 0; kk < 2; ++kk) { const int ks = 2 * kr + kk;
#pragma unroll
                    for (int cb = 0; cb < 16; ++cb) if (2 * ks <= cb) acc[cb] = __builtin_amdgcn_mfma_f32_16x16x32_bf16(wfr[kk][cb], ufr[kk], acc[cb], 0, 0, 0); }
                asm volatile("" ::: "memory");
            }
            __syncthreads();
#pragma unroll
            for (int ks = 0; ks < 4; ++ks) {
                const bf16x8 hf = *(const LAS bf16x8*)(hl + r16 * 136 + 32 * ks + 8 * q4);
#pragma unroll
                for (int cb = 0; cb < 16; ++cb) { const bf16x8 wf = *(const LAS bf16x8*)(W3S + (cb * 16 + r16) * 256 + (((4 * ks + q4) ^ r16) << 4)); acc[cb] = __builtin_amdgcn_mfma_f32_16x16x32_bf16(wf, hf, acc[cb], 0, 0, 0); }
            }
            const int row = rb * 16 + r16, c = row & 127;
            bf16* yp = YG + ((size_t)(nb * L + c * 16) * 512 + g * 16 + 4 * q4);
#pragma unroll
            for (int cb = 0; cb < 16; ++cb) {
                const f32x4 y = gelu4(acc[cb]);
                v2u wv; wv.x = cvt_pk_bf16(y[0], y[1]); wv.y = cvt_pk_bf16(y[2], y[3]);
                *(v2u*)(yp + (size_t)cb * 512) = wv;
            }
            __syncthreads();
        }
    }
    {
        KArgs k = kargs();
        float* out = k->out; const float* V = WSP(float, WS_V); bf16* AMIX = WSP(bf16, WS_AMIX); bf16* YG = WSP(bf16, WS_YG);
        for (size_t i = gt; i < (size_t)(MP / 8) * 128; i += NGT) {
            const int rb8 = (int)(i >> 7), c4 = (int)(i & 127) * 4, gi = c4 >> 7, w = 2 << gi;
            const int row0 = rb8 * 8, tl0 = row0 & (L - 1);
            const float* vp = V + (size_t)row0 * 512 + c4;
            f32x4 r[23];
#pragma unroll
            for (int j = 0; j < 23; ++j) { r[j] = (f32x4){0.f, 0.f, 0.f, 0.f}; if (tl0 + j - 15 >= 0) r[j] = *(const f32x4*)(vp + (ptrdiff_t)(j - 15) * 512); }
#pragma unroll
            for (int j = 0; j < 8; ++j) {
                const int tl = tl0 + j; const int cnt = (tl + 1) < w ? (tl + 1) : w;
                f32x4 sm = r[15 + j];
#pragma unroll
                for (int q = 1; q < 16; ++q) if (q < w) sm += r[15 + j - q];
                const f32x4 o = sm * (1.0f / (float)cnt) - r[15 + j];
                if (tl >= L - 15) *(f32x4*)(out + O_PPOOL + ((size_t)(((row0 + j) >> 11) * 15 + (tl - (L - 15))) * 512 + c4)) = r[15 + j];
                v2u wv; wv.x = cvt_pk_bf16(o[0], o[1]); wv.y = cvt_pk_bf16(o[2], o[3]);
                *(v2u*)(AMIX + (size_t)(row0 + j) * D + 512 + c4) = wv;
            }
        }
        for (size_t i = gt; i < (size_t)(MPAD - MTOT) * 512 / 8; i += NGT) *(v4u*)(YG + (size_t)MTOT * 512 + i * 8) = (v4u){0u, 0u, 0u, 0u};
        {
            const float* g_ffn = KIN(20); const float* w_up = KIN(21); bf16* WUP = WSP(bf16, WS_WUP);
            LAS float* scr = (LAS float*)(lds + wave * 16384);
            for (int r = gw; r < 16 * 176; r += NGW) { const int kb = r / 176, nb = r % 176; const int n0 = 32 * nb, pn = n0 >> 8, lr = n0 & 255; const int src = lr < 128 ? 128 * pn + lr : FF + 128 * pn + (lr - 128);
                transpose_item(w_up, FF2, WUP, D, 64 * kb, n0, src, g_ffn, scr, lane); }
        }
    }
    {
        KArgs k = kargs();
        float* out = k->out; const float* st_re = KIN(2); const float* st_im = KIN(3); const float* st_pool = KIN(4); const float* c_re = KIN(13); const float* c_im = KIN(14); const float* s5_d = KIN(15);
        const float* V = WSP(float, WS_V); bf16* AMIX = WSP(bf16, WS_AMIX); const float* USAMP = WSP(float, WS_USAMP); const f32x2* ABAR = WSP(f32x2, WS_ABAR); const f32x2* BBAR = WSP(f32x2, WS_BBAR); bf16* YG = WSP(bf16, WS_YG);
        for (int task = gw; task < NS * NG; task += NGW) {
            const int ns = task >> 5, g = task & 31; const int gp = g * NP + lane;
            const float* ur = USAMP + (size_t)ns * 512 + g * 16;
            float uu[NH];
#pragma unroll
            for (int h = 0; h < NH; ++h) uu[h] = ur[h];
            f32x2 bu = (f32x2){0.f, 0.f};
#pragma unroll
            for (int h = 0; h < NH; ++h) { const f32x2 bb = BBAR[(size_t)gp * NH + h]; bu.x += bb.x * uu[h]; bu.y += bb.y * uu[h]; }
            const f32x2 h0 = (f32x2){st_re[(size_t)ns * 2048 + gp], st_im[(size_t)ns * 2048 + gp]};
            const f32x2 hn = cmul(ABAR[gp], h0) + bu;
            out[O_SRE + (size_t)ns * 2048 + gp] = hn.x; out[O_SIM + (size_t)ns * 2048 + gp] = hn.y;
            float cr[NH], ci[NH];
#pragma unroll
            for (int h = 0; h < NH; ++h) { cr[h] = c_re[(size_t)(g * NH + h) * NP + lane]; ci[h] = c_im[(size_t)(g * NH + h) * NP + lane]; }
            float t[NH];
#pragma unroll
            for (int h = 0; h < NH; ++h) t[h] = cr[h] * hn.x - ci[h] * hn.y;
            const bool b5 = (lane & 32) != 0, b4 = (lane & 16) != 0, b3 = (lane & 8) != 0, b2 = (lane & 4) != 0;
            float ra[8], rb[4], rc[2];
#pragma unroll
            for (int i = 0; i < 8; ++i) { const float keep = b5 ? t[i + 8] : t[i], send = b5 ? t[i] : t[i + 8]; ra[i] = keep + __shfl_xor(send, 32); }
#pragma unroll
            for (int i = 0; i < 4; ++i) { const float keep = b4 ? ra[i + 4] : ra[i], send = b4 ? ra[i] : ra[i + 4]; rb[i] = keep + __shfl_xor(send, 16); }
#pragma unroll
            for (int i = 0; i < 2; ++i) { const float keep = b3 ? rb[i + 2] : rb[i], send = b3 ? rb[i] : rb[i + 2]; rc[i] = keep + __shfl_xor(send, 8); }
            float rd; { const float keep = b2 ? rc[1] : rc[0], send = b2 ? rc[0] : rc[1]; rd = keep + __shfl_xor(send, 4); }
            rd += __shfl_xor(rd, 2); rd += __shfl_xor(rd, 1);
            const int hsel = (b5 ? 8 : 0) + (b4 ? 4 : 0) + (b3 ? 2 : 0) + (b2 ? 1 : 0);
            const float my = rd + s5_d[g * NH + hsel] * ur[hsel];
            if ((lane & 3) == 0) YG[(size_t)(MP + ns) * 512 + g * 16 + hsel] = (bf16)(cvt_pk_bf16(gelu_exact(my), 0.f) & 0xffffu);
        }
        for (size_t i = gt; i < (size_t)(MPAD - MP) * 128; i += NGT) {
            const int row = MP + (int)(i >> 7), c4 = (int)(i & 127) * 4, gi = c4 >> 7, w = 2 << gi;
            f32x4 o = (f32x4){0.f, 0.f, 0.f, 0.f};
            if (row < MTOT) {
                const int ns = row - MP;
                const f32x4 vt4 = *(const f32x4*)(V + (size_t)row * 512 + c4); f32x4 s = vt4;
                f32x4 bq[15];
#pragma unroll
                for (int q = 1; q < 16; ++q) bq[q - 1] = *(const f32x4*)(st_pool + ((size_t)(ns * 15 + 15 - q) * 512 + c4));
#pragma unroll
                for (int q = 1; q < 16; ++q) if (q < w) s += bq[q - 1];
                o = s * (1.0f / (float)w) - vt4;
                *(f32x4*)(out + O_SPOOL + ((size_t)(ns * 15 + 14) * 512 + c4)) = vt4;
#pragma unroll
                for (int r = 0; r < 14; ++r) *(f32x4*)(out + O_SPOOL + ((size_t)(ns * 15 + r) * 512 + c4)) = bq[13 - r];
            }
            v2u wv; wv.x = cvt_pk_bf16(o[0], o[1]); wv.y = cvt_pk_bf16(o[2], o[3]);
            *(v2u*)(AMIX + (size_t)row * D + 512 + c4) = wv;
        }
    }
    xcd_barrier(xbar);

    {
        KArgs k = kargs();
        bf16* YG = WSP(bf16, WS_YG); bf16* WGLU = WSP(bf16, WS_WGLU); bf16* AMIX = WSP(bf16, WS_AMIX);
        pg8::Gemm g{YG, WGLU, MPAD, 512, 512, 512}; pg8::StaticOrder S; S.init(MPAD, 512, G, bx);
        EpiGlu Ep{YG, AMIX};
        pg8::gemm_phase<EpiGlu, pg8::StaticOrder, true, true, 0>(lds, g, S, Ep);
    }
    if (bx >= 194) {
        KArgs k = kargs();
        const float* w_out = KIN(19); const float* w_down = KIN(24);
        bf16* WMIX = WSP(bf16, WS_WMIX); bf16* WDN = WSP(bf16, WS_WDN);
        const int vw = (bx - 194) * 8 + wave, VNW = (G - 194) * 8;
        LAS float* scr = (LAS float*)(lds + wave * 16384);
        constexpr int I_OUT = 8 * 32, I_DN = 44 * 32;
        for (int it = vw; it < I_OUT + I_DN; it += VNW) {
            int r = it;
            if (r < I_OUT) { const int kb = r / 32, nb = r % 32; transpose_item(w_out, D, WMIX, D, 64 * kb, 32 * nb, 32 * nb, nullptr, scr, lane); continue; } r -= I_OUT;
            { const int kb = r / 32, nb = r % 32; transpose_item(w_down, D, WDN, FF, 64 * kb, 32 * nb, 32 * nb, nullptr, scr, lane); }
        }
    } else if (bx >= 130) {
        KArgs k = kargs();
        const float* pool_w = KIN(17); const float* pool_scale = KIN(18); const float* w_out = KIN(19); bf16* WMIX = WSP(bf16, WS_WMIX);
        const size_t vt = (size_t)(bx - 130) * 512 + tid, VNT = (size_t)64 * 512;
        for (size_t i = vt; i < (size_t)128 * 256; i += VNT) {
            const int n4 = (int)(i & 255) * 4, gc0 = (int)(i >> 8) * 4, g = gc0 >> 7;
            const float* pw = pool_w + (size_t)gc0 * 128; const float* sc = pool_scale + g * 128; const float* wo = w_out + (size_t)(512 + g * 128) * D + n4;
            f32x4 s0 = (f32x4){0.f, 0.f, 0.f, 0.f}, s1 = s0, s2 = s0, s3 = s0;
#pragma unroll 16
            for (int d = 0; d < 128; ++d) {
                const f32x4 wv = *(const f32x4*)(wo + (size_t)d * D) * sc[d];
                s0 += wv * pw[d]; s1 += wv * pw[128 + d]; s2 += wv * pw[256 + d]; s3 += wv * pw[384 + d];
            }
#pragma unroll
            for (int e = 0; e < 4; ++e) {
                v2u w; w.x = cvt_pk_bf16(s0[e], s1[e]); w.y = cvt_pk_bf16(s2[e], s3[e]);
                *(v2u*)(WMIX + (size_t)(n4 + e) * D + 512 + gc0) = w;
            }
        }
    }
    xcd_barrier(xbar);

    {
        KArgs k = kargs();
        float* out = k->out; const float* x_p = KIN(0); const float* x_s = KIN(1); bf16* AMIX = WSP(bf16, WS_AMIX); bf16* WMIX = WSP(bf16, WS_WMIX); bf16* XMIDB = WSP(bf16, WS_XMIDB); float* SS = WSP(float, WS_SS);
        pg8::Gemm g{AMIX, WMIX, MP, D, D, D}; pg8::StaticOrder S; S.init(MP, D, G, bx);
        EpiOut Ep{x_p, x_s, out, XMIDB, SS, WSP(bf16, WS_XN), WSP(float, WS_RINV), KIN(6)};
        pg8::gemm_phase<EpiOut, pg8::StaticOrder, true, true, 0>(lds, g, S, Ep);
    }
    xcd_barrier(xbar);

    {
        KArgs k = kargs();
        bf16* XMIDB = WSP(bf16, WS_XMIDB); bf16* WUP = WSP(bf16, WS_WUP); float* SS = WSP(float, WS_SS); float* HALO = WSP(float, WS_HALO); unsigned* CTR = WSP(unsigned, WS_CTR);
        pg8::Gemm g{XMIDB - 2 * D, WUP, 512, FF2, D, D}; DepOrder S; S.init(512, FF2, G, bx); S.wait_ctr = CTR; S.wait_need = 0; S.wait_pm = -2; S.done_ctr = CTR; S.done_pm = -1; S.done_rel = true;
        EpiHalo Ep{SS, HALO};
        pg8::gemm_phase<EpiHalo, DepOrder, true, true, 1>(lds, g, S, Ep);
    }
    {
        KArgs k = kargs();
        float* out = k->out; const float* x_p = KIN(0); const float* x_s = KIN(1); bf16* AMIX = WSP(bf16, WS_AMIX); bf16* WMIX = WSP(bf16, WS_WMIX); bf16* XMIDB = WSP(bf16, WS_XMIDB); float* SS = WSP(float, WS_SS); unsigned* CTR = WSP(unsigned, WS_CTR);
        pg8::Gemm g{AMIX, WMIX, 256, D, D, D}; DepOrder S; S.init(256, D, G, (bx + G - 44) % G, 64); S.wait_ctr = CTR; S.wait_need = 0; S.wait_pm = -2; S.done_ctr = CTR + 64; S.done_pm = -1;
        EpiOut Ep{x_p, x_s, out, XMIDB, SS, nullptr, nullptr, nullptr};
        pg8::gemm_phase<EpiOut, DepOrder, true, true, 0>(lds, g, S, Ep);
    }
    {
        KArgs k = kargs();
        float* out = k->out; const float* conv_w = KIN(22); const float* conv_b = KIN(23); const float* st_conv = KIN(5); unsigned* CTR = WSP(unsigned, WS_CTR);
        bf16* XMIDB = WSP(bf16, WS_XMIDB); bf16* WUP = WSP(bf16, WS_WUP); float* SS = WSP(float, WS_SS); float* HALO = WSP(float, WS_HALO); bf16* ACT = WSP(bf16, WS_ACT);
        pg8::Gemm g{XMIDB, WUP, MPAD, FF2, D, D}; DepOrder S; S.init(MPAD, FF2, G, (bx + 150) % G);
        S.wait_ctr = CTR + 64; S.wait_need = 4; S.wait_pm = 64; S.done_ctr = CTR + 128; S.done_pm = 64; S.rot = 2;
        EpiUp Ep{ACT, SS, HALO, conv_w, conv_b, st_conv, out + O_PCONV, out + O_SCONV, CTR, 44u, 0};
        pg8::gemm_phase<EpiUp, DepOrder, true, true, 0>(lds, g, S, Ep);
    }
    if (bx >= 60 && bx < 92) {
        KArgs k = kargs();
        float* out = k->out; const bf16* ACT = WSP(bf16, WS_ACT); const bf16* WDN = WSP(bf16, WS_WDN); unsigned* CTR = WSP(unsigned, WS_CTR);
        if (tid < 64) { unsigned sp = 0;
            while ((unsigned)__builtin_amdgcn_readfirstlane(__hip_atomic_load(CTR + 128, __ATOMIC_RELAXED, __HIP_MEMORY_SCOPE_AGENT)) < 22u) { __builtin_amdgcn_s_sleep(8); if (++sp > (1u << 20)) break; }
            __builtin_amdgcn_fence(__ATOMIC_ACQUIRE, "agent"); asm volatile("s_waitcnt vmcnt(0)" ::: "memory"); }
        __syncthreads();
        const int r16 = lane & 15, q4 = lane >> 4, cb0 = (bx - 60) * 2;
        f32x4 pa[2][8];
#pragma unroll
        for (int j = 0; j < 2; ++j)
#pragma unroll
            for (int rbk = 0; rbk < 8; ++rbk) pa[j][rbk] = (f32x4){0.f, 0.f, 0.f, 0.f};
        const bf16* wp = WDN + ((size_t)(16 * cb0 + r16) * FF + 352 * wave + 8 * q4);
        const bf16* ap = ACT + ((size_t)(MP + r16) * FF + 352 * wave + 8 * q4);
#pragma unroll
        for (int ks = 0; ks < 11; ++ks) {
            const bf16x8 wf0 = *(const bf16x8*)(wp + 32 * ks), wf1 = *(const bf16x8*)(wp + (size_t)16 * FF + 32 * ks);
#pragma unroll
            for (int rbk = 0; rbk < 8; ++rbk) { const bf16x8 af = *(const bf16x8*)(ap + (size_t)rbk * 16 * FF + 32 * ks);
                pa[0][rbk] = __builtin_amdgcn_mfma_f32_16x16x32_bf16(wf0, af, pa[0][rbk], 0, 0, 0); pa[1][rbk] = __builtin_amdgcn_mfma_f32_16x16x32_bf16(wf1, af, pa[1][rbk], 0, 0, 0); }
            asm volatile("" ::: "memory");
        }
        LAS f32x4* red = (LAS f32x4*)lds;
#pragma unroll
        for (int j = 0; j < 2; ++j)
#pragma unroll
            for (int rbk = 0; rbk < 8; ++rbk) red[(wave * 16 + j * 8 + rbk) * 64 + lane] = pa[j][rbk];
        __syncthreads();
#pragma unroll
        for (int t = 0; t < 2; ++t) {
            const int b = 2 * wave + t, j = b >> 3, rbk = b & 7;
            f32x4 sm = (f32x4){0.f, 0.f, 0.f, 0.f};
#pragma unroll
            for (int w2 = 0; w2 < 8; ++w2) sm += red[(w2 * 16 + b) * 64 + lane];
            float* p = out + (size_t)(MP + 16 * rbk + r16) * D + 16 * (cb0 + j) + 4 * q4;
            *(f32x4*)p = *(const f32x4*)p + sm;
        }
        __syncthreads();
    }
    xcd_barrier(xbar);

    {
        KArgs k = kargs();
        float* out = k->out; const float* g_fin = KIN(25);
        for (int m = MP + gw; m < MTOT; m += NGW) {
            f32x4* xr4 = (f32x4*)(out + (size_t)m * D) + lane;
            f32x4 v[4]; float sq = 0.f;
#pragma unroll
            for (int j = 0; j < 4; ++j) { v[j] = xr4[64 * j]; sq += (v[j][0] * v[j][0] + v[j][1] * v[j][1]) + (v[j][2] * v[j][2] + v[j][3] * v[j][3]); }
            const float rstd = rsqrtf(wave_sum(sq) * (1.0f / D) + EPS);
#pragma unroll
            for (int j = 0; j < 4; ++j) { const f32x4 gq = ((const f32x4*)g_fin)[lane + 64 * j]; xr4[64 * j] = v[j] * rstd * gq; }
        }
    }
    {
        KArgs k = kargs();
        float* out = k->out; bf16* ACT = WSP(bf16, WS_ACT); bf16* WDN = WSP(bf16, WS_WDN);
        pg8::Gemm g{ACT, WDN, MP, D, FF, FF}; pg8::StaticOrder S; S.init(MP, D, G, bx);
        EpiDownNorm Ep{WSP(bf16, WS_XMIDB), KIN(25), out, WSP(float, WS_XSLOT), WSP(unsigned, WS_CNT)};
        pg8::gemm_phase<EpiDownNorm, pg8::StaticOrder, true, true, 0, true>(lds, g, S, Ep);
    }
}

extern "C" void kernel_launch(void* const* d_in, const int* in_sizes, int n_in, void* d_out, int out_size, void* d_ws, size_t ws_size, hipStream_t stream) {
    static int grid = 0;
    if (grid == 0) {
        int dev = 0, cus = 0, per_cu = 0;
        (void)hipGetDevice(&dev);
        (void)hipDeviceGetAttribute(&cus, hipDeviceAttributeMultiprocessorCount, dev);
        if (hipFuncSetAttribute((const void*)fwd_kernel, hipFuncAttributeMaxDynamicSharedMemorySize, LDS_BYTES) != hipSuccess) { fprintf(stderr, "hipFuncSetAttribute failed\n"); }
        if (hipOccupancyMaxActiveBlocksPerMultiprocessor(&per_cu, (const void*)fwd_kernel, 512, LDS_BYTES) != hipSuccess || per_cu < 1) { fprintf(stderr, "occupancy query: %d\n", per_cu); per_cu = 1; }
        (void)hipGetLastError();
        grid = cus * per_cu;
        if (ws_size < WS_END) fprintf(stderr, "workspace too small: %zu < %zu\n", ws_size, (size_t)WS_END);
    }
    if (hipMemsetAsync((char*)d_ws + WS_BAR, 0, 49152, stream) != hipSuccess) fprintf(stderr, "memset of barrier words failed\n");
    Args a{};
    for (int i = 0; i < 26; ++i) a.in[i] = (const float*)d_in[i];
    a.out = (float*)d_out; a.ws = (unsigned char*)d_ws;
    void* args[] = {&a};
    hipError_t e = hipLaunchCooperativeKernel((const void*)fwd_kernel, dim3(grid), dim3(512), args, LDS_BYTES, stream);
    if (e != hipSuccess) fprintf(stderr, "cooperative launch failed: %s (grid %d)\n", hipGetErrorString(e), grid);
}
```

```cpp
#include <hip/hip_runtime.h>
#include <hip/hip_cooperative_groups.h>
#include <cstdio>
#include <cstdint>
namespace cg = cooperative_groups;

constexpr int D = 1024, NB = 8, L = 2048, MP = NB * L  , NS = 128, MTOT = MP + NS  , MPAD = 16640  ;
constexpr int DS5 = 512, NG = 32, NH = 16, NP = 64, DPOOL = 512, FF = 2816, FF2 = 5632;
constexpr int TCH = 16, NCH = L / TCH  , NROW = NB * NCH  ;
constexpr float EPS = 1e-6f;

constexpr size_t O_Y = 0, O_YS = 16777216, O_PRE = 16908288, O_PIM = 16924672, O_PPOOL = 16941056, O_PCONV = 17002496,
                 O_SRE = 17092608, O_SIM = 17354752, O_SPOOL = 17616896, O_SCONV = 18599936;

constexpr size_t MiB = 1u << 20;
constexpr size_t WS_WIN = 0, WS_WGLU = 2 * MiB, WS_WMIX = 2 * MiB + MiB / 2, WS_WUP = 4 * MiB + MiB / 2, WS_WDN = 15 * MiB + MiB / 2;
constexpr size_t WS_KTAB = 21 * MiB, WS_W2 = 21 * MiB + MiB / 4, WS_W3 = 23 * MiB + MiB / 4, WS_ABAR = 25 * MiB + MiB / 4, WS_AT = WS_ABAR + 16384, WS_BBAR = WS_ABAR + 32768;
constexpr size_t WS_CTR = 26 * MiB + 160 * 1024;
constexpr size_t WS_CNT = 26 * MiB + 144 * 1024;
constexpr size_t WS_RINV = 224 * MiB + MiB / 2 + MiB / 4;
constexpr size_t WS_XSLOT = 224 * MiB + MiB / 2;
constexpr size_t WS_BAR = 26 * MiB + 128 * 1024;
constexpr size_t WS_SS = 26 * MiB, WS_USAMP = 26 * MiB + MiB / 4, WS_APW = 26 * MiB + MiB / 2;
constexpr size_t WS_XN = 27 * MiB, WS_UPERM = WS_XN + (size_t)MPAD * D * 2, WS_V = WS_UPERM + 16 * MiB, WS_E = WS_V + (size_t)MPAD * 512 * 4,
                 WS_HIN = WS_E + 16 * MiB, WS_YG = WS_HIN + 8 * MiB, WS_AMIX = WS_YG + (size_t)MPAD * 512 * 2, WS_XMIDB = WS_AMIX + (size_t)MPAD * D * 2,
                 WS_HALO = WS_XMIDB + (size_t)MPAD * D * 2, WS_END = WS_HALO + (size_t)512 * FF2 * 4;
constexpr size_t WS_ACT = WS_XN;
static_assert(WS_END <= 256 * MiB, "ws map");
static_assert(WS_ACT + (size_t)MPAD * FF * 2 <= WS_YG, "ACT overlay must stay below live buffers");

constexpr int LDS_BYTES = 147456;

#define LAS __attribute__((address_space(3)))
typedef unsigned short bf16;
typedef unsigned v4u __attribute__((ext_vector_type(4)));
typedef unsigned v2u __attribute__((ext_vector_type(2)));
typedef float f32x4 __attribute__((ext_vector_type(4)));
typedef float f32x2 __attribute__((ext_vector_type(2)));
typedef short bf16x8 __attribute__((ext_vector_type(8)));
#define LDS_WAIT() asm volatile("s_waitcnt lgkmcnt(0)" ::: "memory")

__device__ __forceinline__ unsigned cvt_pk_bf16(float lo, float hi) { unsigned r; asm volatile("v_cvt_pk_bf16_f32 %0, %1, %2" : "=v"(r) : "v"(lo), "v"(hi)); return r; }
__device__ __forceinline__ float bf2f(unsigned b) { return __uint_as_float(b << 16); }
__device__ __forceinline__ float gelu_exact(float v) { return 0.5f * v * (1.0f + erff(v * 0.70710678118654752f)); }
__device__ __forceinline__ f32x2 gelu_pk(f32x2 v) {
    const f32x2 av = __builtin_elementwise_abs(v), d = av * 0.2316418882f + 1.0f;
    f32x2 t; t.x = __builtin_amdgcn_rcpf(d.x); t.y = __builtin_amdgcn_rcpf(d.y);
    f32x2 q = t * 0.5307027145f + (-0.7265760135f); q = q * t + 0.7107068705f; q = q * t + (-0.142248368f); q = q * t + 0.127414796f; q = q * t;
    const f32x2 s = (v * v) * (-0.72134752044f);
    f32x2 e; e.x = __builtin_amdgcn_exp2f(s.x); e.y = __builtin_amdgcn_exp2f(s.y);
    const f32x2 m = v * (q * e), r = v - m;
    f32x2 o; o.x = v.x < 0.f ? m.x : r.x; o.y = v.y < 0.f ? m.y : r.y; return o;
}
__device__ __forceinline__ f32x4 gelu4(f32x4 v) { f32x2 a = gelu_pk((f32x2){v[0], v[1]}), b = gelu_pk((f32x2){v[2], v[3]}); return (f32x4){a.x, a.y, b.x, b.y}; }
__device__ __forceinline__ float sigmoidf_(float x) { return __builtin_amdgcn_rcpf(1.0f + __expf(-x)); }
__device__ __forceinline__ float wave_sum(float v) {
#pragma unroll
    for (int o = 1; o < 64; o <<= 1) v += __shfl_xor(v, o);
    return v;
}

namespace pg8 {
#define PG8_LAS __attribute__((address_space(3)))
typedef unsigned short bf16_t;
constexpr int BM = 256, BK = 64, HALF = 128, HTB = HALF * BK * 2, STAGE_BYTES = 8 * HTB, NXCD = 8, WGM = 8;
__host__ __device__ __forceinline__ int lds_byte(int r, int c) { const int st = (r >> 4) * 2 + (c >> 5), rr = r & 15, cc = c & 31, ob = rr * 64 + cc * 2; return st * 1024 + (ob ^ (((ob >> 9) & 1) << 5)); }
__host__ __device__ __forceinline__ void stage_rc(int b, int& R, int& C) { const int st = b / 1024, sb = b % 1024, swz = sb ^ (((sb >> 9) & 1) << 5); R = (st >> 1) * 16 + swz / 64; C = (st & 1) * 32 + (swz % 64) / 2; }
__host__ __device__ __forceinline__ int perm32(int rho) { const int n = rho >> 4, i = rho & 15; return 8 * (i >> 2) + 4 * n + (i & 3); }
struct Unit { int pm, pn; };
struct Gemm { const bf16_t* A; const bf16_t* Bt; int M, N, K, ld; };
struct StaticOrder {
    int nM, nN, nwg, G, c, pm_off, lim, L_off;
    __host__ __device__ void init(int M, int N, int G_, int c_, int pm_off_ = 0) { nM = M / BM; nN = N / BM; nwg = nM * nN; G = G_; c = c_; pm_off = pm_off_; lim = nwg; L_off = 0; }
    __host__ __device__ __forceinline__ bool next(int i, Unit& u) const { return from_L(L_off + i * G + c, u); }
    __host__ __device__ __forceinline__ bool from_L(int Lq, Unit& u) const {
        if (Lq >= lim) return false;
        int wgid = Lq; { const int q = nwg / NXCD, r = nwg % NXCD, xcd = wgid % NXCD, off = wgid / NXCD; wgid = (xcd < r ? xcd * (q + 1) : r * (q + 1) + (xcd - r) * q) + off; }
        const int nig = WGM * nN, gid = wgid / nig, fm = gid * WGM, gsz = (nM - fm) < WGM ? (nM - fm) : WGM;
        u.pm = pm_off + fm + ((wgid % nig) % gsz); u.pn = (wgid % nig) / gsz; return true;
    }
    __device__ __forceinline__ void a_ready(const Unit&) const {}
    __device__ __forceinline__ void done(const Unit&) const {}
};
template <class Epi, class Sched, bool ALIGN_EPI = false, bool SP2 = false, int AMODE = 0, bool AFTER_DRAIN = false>
__device__ __forceinline__ void gemm_phase(PG8_LAS unsigned char* lds, const Gemm g, const Sched& S, const Epi& E) {
    int tid_ = threadIdx.x; asm volatile("" : "+v"(tid_));
    const int tid = tid_, wid = __builtin_amdgcn_readfirstlane(tid >> 6), lane = tid & 63, wr = wid >> 2, wc = wid & 3, fr = lane & 15, fq = lane >> 4;
    const int K = g.K, nt = K / BK;
    unsigned voffA[2], voffB[2];
#pragma unroll
    for (int i = 0; i < 2; ++i) { int R, C; stage_rc(tid * 16 + i * 8192, R, C); const int Rb = Epi::PERM ? ((R & ~31) + perm32(R & 31)) : R;
        const int Ra = (AMODE == 1) ? (32 * R - 31 * (R & 1)) : R;
        voffA[i] = (unsigned)(Ra * g.ld + C) * 2u; voffB[i] = (unsigned)(Rb * g.ld + C) * 2u; }
    const size_t kstep = (size_t)(BK * 2);
    const size_t hstepB = (size_t)HALF * g.ld * 2, tstepB = 2 * hstepB;
    const size_t hstepA = (AMODE == 1) ? hstepB * 32 : hstepB, tstepA = 2 * hstepA;
    const unsigned ldsw = (unsigned)wid * 1024u;
    const int aoff = lds_byte(wr * 64 + fr, fq * 8), boff = lds_byte(wc * 32 + fr, fq * 8);
#define PG8_SA(b, h) (((b) * 2 + (h)) * HTB)
#define PG8_SB(b, h) ((4 + (b) * 2 + (h)) * HTB)
#define PG8_STAGE(bufoff, gbase, voff) do { _Pragma("unroll") for (int _i = 0; _i < 2; ++_i) \
        __builtin_amdgcn_global_load_lds((const unsigned*)((const char*)(gbase) + (voff)[_i]), (PG8_LAS unsigned*)(lds + (bufoff) + ldsw + _i * 8192), 16, 0, 0); } while (0)
#define PG8_LDA(dst, b, h) do { _Pragma("unroll") for (int m = 0; m < 4; ++m) _Pragma("unroll") for (int k = 0; k < 2; ++k) dst[m][k] = *(const PG8_LAS bf16x8*)(lds + PG8_SA(b, h) + aoff + m * 2048 + k * 1024); } while (0)
#define PG8_LDB(dst, b, h) do { _Pragma("unroll") for (int n = 0; n < 2; ++n) _Pragma("unroll") for (int k = 0; k < 2; ++k) dst[n][k] = *(const PG8_LAS bf16x8*)(lds + PG8_SB(b, h) + boff + n * 2048 + k * 1024); } while (0)
#define PG8_MMA(ai, bj, At, Bt) do { __builtin_amdgcn_s_setprio(1); _Pragma("unroll") for (int m = 0; m < 4; ++m) _Pragma("unroll") for (int n = 0; n < 2; ++n) _Pragma("unroll") for (int k = 0; k < 2; ++k) \
        acc[ai][bj][m][n] = __builtin_amdgcn_mfma_f32_16x16x32_bf16(Bt[n][k], At[m][k], acc[ai][bj][m][n], 0, 0, 0); __builtin_amdgcn_s_setprio(0); } while (0)
#define PG8_WAIT_V(n) asm volatile("s_waitcnt vmcnt(" #n ")" ::: "memory")
#define PG8_WAIT_L(n) asm volatile("s_waitcnt lgkmcnt(" #n ")" ::: "memory")
#define PG8_BAR __builtin_amdgcn_s_barrier()
#define PG8_SCHED __builtin_amdgcn_sched_barrier(0)
    Unit cur, nxt; int ui = 0;
    if (!S.next(0, cur)) return;
    f32x4 acc[2][2][4][2];
#pragma unroll
    for (int a = 0; a < 2; ++a)
#pragma unroll
        for (int b = 0; b < 2; ++b)
#pragma unroll
            for (int m = 0; m < 4; ++m)
#pragma unroll
                for (int n = 0; n < 2; ++n) acc[a][b][m][n] = (f32x4){0.f, 0.f, 0.f, 0.f};
    bf16x8 At[4][2], B0[2][2], B1[2][2];
    const char* cA = (const char*)g.A + (size_t)cur.pm * tstepA; const char* cB = (const char*)g.Bt + (size_t)cur.pn * tstepB;
    S.a_ready(cur);
    if constexpr (SP2) {
        PG8_STAGE(PG8_SB(0, 0), cB, voffB); PG8_STAGE(PG8_SB(0, 1), cB + hstepB, voffB); PG8_STAGE(PG8_SA(0, 0), cA, voffA); PG8_STAGE(PG8_SA(0, 1), cA + hstepA, voffA);
        if (wr == 1) PG8_BAR;
        PG8_WAIT_V(2); PG8_BAR;
        PG8_STAGE(PG8_SB(1, 0), cB + kstep, voffB); PG8_STAGE(PG8_SA(1, 0), cA + kstep, voffA); PG8_STAGE(PG8_SB(1, 1), cB + hstepB + kstep, voffB);
        PG8_WAIT_V(6); PG8_BAR;
    } else {
        PG8_STAGE(PG8_SB(0, 0), cB, voffB); PG8_STAGE(PG8_SA(0, 0), cA, voffA); PG8_STAGE(PG8_SB(0, 1), cB + hstepB, voffB); PG8_STAGE(PG8_SA(0, 1), cA + hstepA, voffA);
        if (wr == 1) PG8_BAR;
        PG8_WAIT_V(4); PG8_BAR;
        PG8_STAGE(PG8_SB(1, 0), cB + kstep, voffB); PG8_STAGE(PG8_SA(1, 0), cA + kstep, voffA); PG8_STAGE(PG8_SB(1, 1), cB + hstepB + kstep, voffB);
        PG8_WAIT_V(6); PG8_BAR;
    }
    for (;;) {
        const bool has_next = S.next(ui + 1, nxt);
        const char* nA = has_next ? (const char*)g.A + (size_t)nxt.pm * tstepA : cA; const char* nB = has_next ? (const char*)g.Bt + (size_t)nxt.pn * tstepB : cB;
        for (int t = 0; t < nt; t += 2) {
            const bool last = (t == nt - 2);
            const char* a1 = cA + (size_t)(t + 1) * kstep;
            const char* a2 = last ? nA : cA + (size_t)(t + 2) * kstep; const char* b2 = last ? nB : cB + (size_t)(t + 2) * kstep;
            const char* a3 = a2 + kstep; const char* b3 = b2 + kstep;
            if (last && has_next) S.a_ready(nxt);
            if constexpr (SP2) {
            PG8_LDB(B0, 0, 0); PG8_LDB(B1, 0, 1); PG8_SCHED; PG8_LDA(At, 0, 0); PG8_STAGE(PG8_SA(1, 1), a1 + hstepA, voffA);
            PG8_WAIT_V(8); PG8_WAIT_L(0); PG8_BAR; PG8_MMA(0, 0, At, B0); PG8_MMA(0, 1, At, B1); PG8_BAR; PG8_SCHED;
            PG8_LDA(At, 0, 1); PG8_STAGE(PG8_SB(0, 0), b2, voffB); PG8_STAGE(PG8_SB(0, 1), b2 + hstepB, voffB); PG8_STAGE(PG8_SA(0, 0), a2, voffA);
            PG8_WAIT_V(8); PG8_WAIT_L(0); PG8_BAR; PG8_MMA(1, 0, At, B0); PG8_MMA(1, 1, At, B1); PG8_BAR; PG8_SCHED;
            PG8_LDB(B0, 1, 0); PG8_LDB(B1, 1, 1); PG8_SCHED; PG8_LDA(At, 1, 0); PG8_STAGE(PG8_SA(0, 1), a2 + hstepA, voffA);
            PG8_WAIT_V(8); PG8_WAIT_L(0); PG8_BAR; PG8_MMA(0, 0, At, B0); PG8_MMA(0, 1, At, B1); PG8_BAR; PG8_SCHED;
            PG8_LDA(At, 1, 1); PG8_STAGE(PG8_SB(1, 0), b3, voffB); PG8_STAGE(PG8_SB(1, 1), b3 + hstepB, voffB); PG8_STAGE(PG8_SA(1, 0), a3, voffA);
            PG8_WAIT_V(8); PG8_WAIT_L(0); PG8_BAR; PG8_MMA(1, 0, At, B0); PG8_MMA(1, 1, At, B1); PG8_BAR; PG8_SCHED;
            } else {
            PG8_LDB(B0, 0, 0); PG8_SCHED; PG8_LDA(At, 0, 0); PG8_STAGE(PG8_SA(1, 1), a1 + hstepA, voffA);
            PG8_WAIT_L(8); PG8_BAR; PG8_WAIT_L(0); PG8_MMA(0, 0, At, B0); PG8_BAR; PG8_SCHED;
            PG8_LDB(B1, 0, 1); PG8_STAGE(PG8_SB(0, 0), b2, voffB);
            PG8_BAR; PG8_WAIT_L(0); PG8_MMA(0, 1, At, B1); PG8_BAR;
            PG8_LDA(At, 0, 1); PG8_STAGE(PG8_SA(0, 0), a2, voffA);
            PG8_BAR; PG8_WAIT_L(0); PG8_MMA(1, 0, At, B0); PG8_BAR; PG8_SCHED;
            PG8_STAGE(PG8_SB(0, 1), b2 + hstepB, voffB);
            PG8_WAIT_V(6); PG8_BAR; PG8_MMA(1, 1, At, B1); PG8_BAR;
            PG8_LDB(B0, 1, 0); PG8_SCHED; PG8_LDA(At, 1, 0); PG8_STAGE(PG8_SA(0, 1), a2 + hstepA, voffA);
            PG8_WAIT_L(8); PG8_BAR; PG8_WAIT_L(0); PG8_MMA(0, 0, At, B0); PG8_BAR; PG8_SCHED;
            PG8_LDB(B1, 1, 1); PG8_STAGE(PG8_SB(1, 0), b3, voffB);
            PG8_BAR; PG8_WAIT_L(0); PG8_MMA(0, 1, At, B1); PG8_BAR;
            PG8_LDA(At, 1, 1); PG8_STAGE(PG8_SA(1, 0), a3, voffA);
            PG8_BAR; PG8_WAIT_L(0); PG8_MMA(1, 0, At, B0); PG8_BAR; PG8_SCHED;
            PG8_STAGE(PG8_SB(1, 1), b3 + hstepB, voffB);
            PG8_WAIT_V(6); PG8_BAR; PG8_MMA(1, 1, At, B1); PG8_BAR;
            }
        }
        if constexpr (ALIGN_EPI) { if (wr == 0) PG8_BAR; }
        if constexpr (!AFTER_DRAIN) { E(acc, cur, wr, wc, fr, fq); S.done(cur); }
        if (!has_next) break;
#pragma unroll
        for (int a = 0; a < 2; ++a)
#pragma unroll
            for (int b = 0; b < 2; ++b)
#pragma unroll
                for (int m = 0; m < 4; ++m)
#pragma unroll
                    for (int n = 0; n < 2; ++n) acc[a][b][m][n] = (f32x4){0.f, 0.f, 0.f, 0.f};
        cur = nxt; cA = nA; cB = nB; ++ui;
        if constexpr (ALIGN_EPI) { if (wr == 1) PG8_BAR; }
    }
    PG8_WAIT_V(0);
    if constexpr (!ALIGN_EPI) { if (wr == 0) PG8_BAR; }
    PG8_BAR;
    if constexpr (AFTER_DRAIN) { E.fused(acc, cur, wr, wc, fr, fq, lds, wid, lane); }
#undef PG8_SA
#undef PG8_SB
#undef PG8_STAGE
#undef PG8_LDA
#undef PG8_LDB
#undef PG8_MMA
#undef PG8_WAIT_V
#undef PG8_WAIT_L
#undef PG8_BAR
#undef PG8_SCHED
}
}
using pg8::Unit;

struct EpiProj {
    static constexpr bool PERM = true;
    bf16* UPERM; float* USAMP; float* V;
    __device__ __forceinline__ void operator()(const f32x4 (&acc)[2][2][4][2], const Unit& u, int wr, int wc, int fr, int fq) const {
#pragma unroll
        for (int ai = 0; ai < 2; ++ai)
#pragma unroll
            for (int m = 0; m < 4; ++m) {
                const int row = u.pm * 256 + ai * 128 + wr * 64 + m * 16 + fr;
#pragma unroll
                for (int bj = 0; bj < 2; ++bj) {
                    const int col0 = u.pn * 256 + bj * 128 + wc * 32 + fq * 8;
                    const f32x4 v0 = acc[ai][bj][m][0], v1 = acc[ai][bj][m][1];
                    if (u.pn < 2) {
                        if (u.pm < 64) {
                            const int g = col0 >> 4, h0 = col0 & 15, nb = row >> 11, tl = row & 2047, c = tl >> 4, j = tl & 15;
                            v4u w; w.x = cvt_pk_bf16(v0[0], v0[1]); w.y = cvt_pk_bf16(v0[2], v0[3]); w.z = cvt_pk_bf16(v1[0], v1[1]); w.w = cvt_pk_bf16(v1[2], v1[3]);
                            *(v4u*)(UPERM + ((size_t)(g * NROW + nb * NCH + c) * 256 + j * 16 + h0)) = w;
                        } else {
                            const int ns = row - MP;
                            if (ns < NS) { *(f32x4*)(USAMP + (size_t)ns * 512 + col0) = v0; *(f32x4*)(USAMP + (size_t)ns * 512 + col0 + 4) = v1; }
                        }
                    } else {
                        float* p = V + (size_t)row * 512 + (col0 - 512);
                        *(f32x4*)p = v0; *(f32x4*)(p + 4) = v1;
                    }
                }
            }
    }
};
struct EpiGlu {
    static constexpr bool PERM = true;
    const bf16* YG; bf16* AMIX;
    __device__ __forceinline__ void operator()(const f32x4 (&acc)[2][2][4][2], const Unit& u, int wr, int wc, int fr, int fq) const {
#pragma unroll
        for (int ai = 0; ai < 2; ++ai)
#pragma unroll
            for (int m = 0; m < 4; ++m) {
                const int row = u.pm * 256 + ai * 128 + wr * 64 + m * 16 + fr;
#pragma unroll
                for (int bj = 0; bj < 2; ++bj) {
                    const int col0 = u.pn * 256 + bj * 128 + wc * 32 + fq * 8;
                    const f32x4 v0 = acc[ai][bj][m][0], v1 = acc[ai][bj][m][1];
                    const v4u y = *(const v4u*)(YG + (size_t)row * 512 + col0);
                    float o[8];
                    o[0] = bf2f(y.x & 0xffffu) * sigmoidf_(v0[0]); o[1] = bf2f(y.x >> 16) * sigmoidf_(v0[1]);
                    o[2] = bf2f(y.y & 0xffffu) * sigmoidf_(v0[2]); o[3] = bf2f(y.y >> 16) * sigmoidf_(v0[3]);
                    o[4] = bf2f(y.z & 0xffffu) * sigmoidf_(v1[0]); o[5] = bf2f(y.z >> 16) * sigmoidf_(v1[1]);
                    o[6] = bf2f(y.w & 0xffffu) * sigmoidf_(v1[2]); o[7] = bf2f(y.w >> 16) * sigmoidf_(v1[3]);
                    v4u w; w.x = cvt_pk_bf16(o[0], o[1]); w.y = cvt_pk_bf16(o[2], o[3]); w.z = cvt_pk_bf16(o[4], o[5]); w.w = cvt_pk_bf16(o[6], o[7]);
                    *(v4u*)(AMIX + (size_t)row * D + col0) = w;
                }
                if (m == 3) asm volatile("" ::: "memory");
            }
    }
};
struct EpiOut {
    static constexpr bool PERM = true;
    const float* xp; const float* xs; float* out; bf16* XMIDB; float* SS; const bf16* XN; const float* RINV; const float* gmix;
    __device__ __forceinline__ void operator()(const f32x4 (&acc)[2][2][4][2], const Unit& u, int wr, int wc, int fr, int fq) const {
        const bool recon = (XN != nullptr) && (u.pm < 64);
        f32x4 gi[2][2];
        if (recon) {
#pragma unroll
            for (int bj = 0; bj < 2; ++bj) { const int col0 = u.pn * 256 + bj * 128 + wc * 32 + fq * 8;
#pragma unroll
                for (int n = 0; n < 2; ++n) { const f32x4 gq = *(const f32x4*)(gmix + col0 + 4 * n);
                    gi[bj][n] = (f32x4){__builtin_amdgcn_rcpf(gq[0]), __builtin_amdgcn_rcpf(gq[1]), __builtin_amdgcn_rcpf(gq[2]), __builtin_amdgcn_rcpf(gq[3])}; } }
        }
#pragma unroll
        for (int ai = 0; ai < 2; ++ai)
#pragma unroll
            for (int m = 0; m < 4; ++m) {
                const int row = u.pm * 256 + ai * 128 + wr * 64 + m * 16 + fr;
                const bool valid = row < MTOT;
                const float* xr = row < MP ? xp + (size_t)row * D : xs + (size_t)(valid ? row - MP : 0) * D;
                const float ri = recon ? RINV[row] : 0.f;
                float ss = 0.f;
#pragma unroll
                for (int bj = 0; bj < 2; ++bj) {
                    const int col0 = u.pn * 256 + bj * 128 + wc * 32 + fq * 8;
                    f32x4 x0 = (f32x4){0.f, 0.f, 0.f, 0.f}, x1 = x0;
                    if (recon) {
                        const v4u xb = *(const v4u*)(XN + (size_t)row * D + col0);
                        x0 = (f32x4){bf2f(xb.x & 0xffffu), bf2f(xb.x >> 16), bf2f(xb.y & 0xffffu), bf2f(xb.y >> 16)} * gi[bj][0] * ri;
                        x1 = (f32x4){bf2f(xb.z & 0xffffu), bf2f(xb.z >> 16), bf2f(xb.w & 0xffffu), bf2f(xb.w >> 16)} * gi[bj][1] * ri;
                    } else if (valid) { x0 = *(const f32x4*)(xr + col0); x1 = *(const f32x4*)(xr + col0 + 4); }
                    const f32x4 v0 = acc[ai][bj][m][0] + x0, v1 = acc[ai][bj][m][1] + x1;
                    ss += (v0[0] * v0[0] + v0[1] * v0[1]) + (v0[2] * v0[2] + v0[3] * v0[3]) + (v1[0] * v1[0] + v1[1] * v1[1]) + (v1[2] * v1[2] + v1[3] * v1[3]);
                    if (valid && row >= MP) { *(f32x4*)(out + (size_t)row * D + col0) = v0; *(f32x4*)(out + (size_t)row * D + col0 + 4) = v1; }
                    v4u w; w.x = cvt_pk_bf16(v0[0], v0[1]); w.y = cvt_pk_bf16(v0[2], v0[3]); w.z = cvt_pk_bf16(v1[0], v1[1]); w.w = cvt_pk_bf16(v1[2], v1[3]);
                    *(v4u*)(XMIDB + (size_t)row * D + col0) = w;
                }
                ss += __shfl_xor(ss, 16); ss += __shfl_xor(ss, 32);
                if (fq == 0) atomicAdd(SS + row, ss);
                if (m & 1) asm volatile("" ::: "memory");
            }
    }
};
struct EpiHalo {
    static constexpr bool PERM = true;
    const float* SS; float* HALO;
    __device__ __forceinline__ void operator()(const f32x4 (&acc)[2][2][4][2], const Unit& u, int wr, int wc, int fr, int fq) const {
#pragma unroll
        for (int ai = 0; ai < 2; ++ai)
#pragma unroll
            for (int m = 0; m < 4; ++m) {
                const int hr = u.pm * 256 + ai * 128 + wr * 64 + m * 16 + fr;
                const int orig = 32 * hr - 31 * (hr & 1) - 2;
                const float rs = orig >= 0 ? rsqrtf(SS[orig] * (1.0f / D) + EPS) : 0.f;
#pragma unroll
                for (int bj = 0; bj < 2; ++bj) {
                    const int col0 = u.pn * 256 + bj * 128 + wc * 32 + fq * 8;
                    float* p = HALO + (size_t)hr * FF2 + col0;
                    const f32x4 h0 = acc[ai][bj][m][0] * rs, h1 = acc[ai][bj][m][1] * rs;
                    asm volatile("global_store_dwordx4 %0, %1, off sc1\n\ts_nop 1" :: "v"(p), "v"(h0) : "memory");
                    asm volatile("global_store_dwordx4 %0, %1, off offset:16 sc1\n\ts_nop 1" :: "v"(p), "v"(h1) : "memory");
                }
            }
    }
};
struct EpiUp {
    static constexpr bool PERM = true;
    bf16* ACT; const float* SS; const float* HALO; const float* convw; const float* convb; const float* state; float* ncp; float* ncs;
    unsigned* halo_ctr; unsigned halo_need; mutable int halo_ok;
    __device__ __forceinline__ void operator()(const f32x4 (&acc)[2][2][4][2], const Unit& u, int wr, int wc, int fr, int fq) const {
        const int lane = threadIdx.x & 63;
        if (!halo_ok) {
            if (threadIdx.x < 64) { unsigned sp = 0;
                while ((unsigned)__builtin_amdgcn_readfirstlane(__hip_atomic_load(halo_ctr, __ATOMIC_RELAXED, __HIP_MEMORY_SCOPE_AGENT)) < halo_need) { __builtin_amdgcn_s_sleep(8); if (++sp > (1u << 20)) break; }
                __builtin_amdgcn_fence(__ATOMIC_ACQUIRE, "agent"); asm volatile("s_waitcnt vmcnt(0)" ::: "memory"); }
            asm volatile("" ::: "memory"); __builtin_amdgcn_s_barrier(); asm volatile("" ::: "memory");
            halo_ok = 1;
        }
        const bool samp = (u.pm == 64);
#pragma unroll
        for (int ai = 0; ai < 2; ++ai) {
            const int rowb = u.pm * 256 + ai * 128 + wr * 64;
            const int blk = 4 * u.pm + 2 * ai + wr;
            float rs[4];
#pragma unroll
            for (int m = 0; m < 4; ++m) rs[m] = rsqrtf(SS[rowb + 16 * m + fr] * (1.0f / D) + EPS);
#pragma unroll
            for (int n = 0; n < 2; ++n) {
                f32x4 cg[4];
#pragma unroll
                for (int bj = 0; bj < 2; ++bj) {
                    const int oc = (bj ? FF : 0) + 128 * u.pn + 32 * wc + 8 * fq + 4 * n;
                    const int cgc = 256 * u.pn + 128 * bj + 32 * wc + 8 * fq + 4 * n;
                    const f32x4 cw0 = *(const f32x4*)(convw + oc), cw1 = *(const f32x4*)(convw + FF2 + oc), cw2 = *(const f32x4*)(convw + 2 * FF2 + oc), cb = *(const f32x4*)(convb + oc);
                    f32x4 v[4];
#pragma unroll
                    for (int m = 0; m < 4; ++m) v[m] = acc[ai][bj][m][n] * rs[m];
                    f32x4 hv = (f32x4){0.f, 0.f, 0.f, 0.f};
                    if (!samp) {
                        if ((blk & 31) != 0 && fr >= 14) hv = *(const f32x4*)(HALO + (size_t)(2 * blk + fr - 14) * FF2 + cgc);
                        if ((u.pm & 7) == 7 && ai == 1 && wr == 1 && fr >= 14) *(f32x4*)(ncp + (size_t)((u.pm >> 3) * 2 + (fr - 14)) * FF2 + oc) = v[3];
                    }
#pragma unroll
                    for (int m = 0; m < 4; ++m) {
                        f32x4 cv;
                        if (!samp) {
                            const f32x4 prev = m ? v[m - 1] : hv;
#pragma unroll
                            for (int e = 0; e < 4; ++e) {
                                const int vi = __float_as_int(v[m][e]), pi = __float_as_int(prev[e]);
                                const int o1 = __builtin_amdgcn_mov_dpp(pi, 0x121, 0xf, 0xf, false);
                                const int o2 = __builtin_amdgcn_mov_dpp(pi, 0x122, 0xf, 0xf, false);
                                const float p1 = __int_as_float(__builtin_amdgcn_update_dpp(o1, vi, 0x111, 0xf, 0xf, false));
                                const float p2 = __int_as_float(__builtin_amdgcn_update_dpp(o2, vi, 0x112, 0xf, 0xf, false));
                                cv[e] = cb[e] + cw0[e] * p2 + cw1[e] * p1 + cw2[e] * v[m][e];
                            }
                        } else {
                            const int ns = rowb + 16 * m + fr - MP;
                            f32x4 s0 = (f32x4){0.f, 0.f, 0.f, 0.f}, s1 = s0;
                            if (ns < NS) {
                                s0 = *(const f32x4*)(state + (size_t)(ns * 2 + 0) * FF2 + oc); s1 = *(const f32x4*)(state + (size_t)(ns * 2 + 1) * FF2 + oc);
                                *(f32x4*)(ncs + (size_t)(ns * 2 + 0) * FF2 + oc) = s1; *(f32x4*)(ncs + (size_t)(ns * 2 + 1) * FF2 + oc) = v[m];
                            }
                            cv = cb + cw0 * s0 + cw1 * s1 + cw2 * v[m];
                        }
                        if (bj == 0) cg[m] = gelu4(cv);
                        else {
                            const f32x4 r = cg[m] * cv;
                            v2u w; w.x = cvt_pk_bf16(r[0], r[1]); w.y = cvt_pk_bf16(r[2], r[3]);
                            *(v2u*)(ACT + (size_t)(rowb + 16 * m + fr) * FF + 128 * u.pn + 32 * wc + 8 * fq + 4 * n) = w;
                        }
                    }
                    asm volatile("" ::: "memory");
                }
            }
        }
    }
};
template <bool ATOMIC> struct EpiDown {
    static constexpr bool PERM = true;
    float* out;
    __device__ __forceinline__ void operator()(const f32x4 (&acc)[2][2][4][2], const Unit& u, int wr, int wc, int fr, int fq) const {
#pragma unroll
        for (int ai = 0; ai < 2; ++ai)
#pragma unroll
            for (int m = 0; m < 4; ++m) {
                const int row = u.pm * 256 + ai * 128 + wr * 64 + m * 16 + fr;
                if (row < MTOT) {
#pragma unroll
                    for (int bj = 0; bj < 2; ++bj) {
                        const int col0 = u.pn * 256 + bj * 128 + wc * 32 + fq * 8;
                        float* p = out + (size_t)row * D + col0;
                        if (ATOMIC) {
#pragma unroll
                            for (int e = 0; e < 4; ++e) { atomicAdd(p + e, acc[ai][bj][m][0][e]); atomicAdd(p + 4 + e, acc[ai][bj][m][1][e]); }
                        } else {
                            const f32x4 x0 = *(const f32x4*)p, x1 = *(const f32x4*)(p + 4);
                            *(f32x4*)p = x0 + acc[ai][bj][m][0]; *(f32x4*)(p + 4) = x1 + acc[ai][bj][m][1];
                        }
                    }
                }
                asm volatile("" ::: "memory");
            }
    }
};


struct EpiDownNorm {
    static constexpr bool PERM = true;
    const bf16* XMIDB; const float* gfin; float* out; float* xslot; unsigned* cnt;
    __device__ __forceinline__ void fused(f32x4 (&acc)[2][2][4][2], const Unit& u, int wr, int wc, int fr, int fq, LAS unsigned char* lds, int wid, int lane) const {
        LAS float* P = (LAS float*)lds;
        LAS float* S = (LAS float*)(lds + 4096);
#pragma unroll
        for (int ai = 0; ai < 2; ++ai)
#pragma unroll
            for (int m = 0; m < 4; ++m) {
                const int r = ai * 128 + wr * 64 + m * 16 + fr; const size_t row = (size_t)u.pm * 256 + r;
                float ss = 0.f;
#pragma unroll
                for (int bj = 0; bj < 2; ++bj) {
                    const int col0 = u.pn * 256 + bj * 128 + wc * 32 + fq * 8;
                    const v4u xb = *(const v4u*)(XMIDB + row * D + col0);
                    f32x4 v0 = acc[ai][bj][m][0], v1 = acc[ai][bj][m][1];
                    v0[0] += bf2f(xb.x & 0xffffu); v0[1] += bf2f(xb.x >> 16); v0[2] += bf2f(xb.y & 0xffffu); v0[3] += bf2f(xb.y >> 16);
                    v1[0] += bf2f(xb.z & 0xffffu); v1[1] += bf2f(xb.z >> 16); v1[2] += bf2f(xb.w & 0xffffu); v1[3] += bf2f(xb.w >> 16);
                    acc[ai][bj][m][0] = v0; acc[ai][bj][m][1] = v1;
                    ss += (v0[0] * v0[0] + v0[1] * v0[1]) + (v0[2] * v0[2] + v0[3] * v0[3]) + (v1[0] * v1[0] + v1[1] * v1[1]) + (v1[2] * v1[2] + v1[3] * v1[3]);
                }
                ss += __shfl_xor(ss, 16); ss += __shfl_xor(ss, 32);
                if (fq == 0) P[r * 4 + wc] = ss;
                if (m == 3) asm volatile("" ::: "memory");
            }
        __syncthreads();
        const int row = wid * 32 + (lane & 31);
        if (lane < 32) {
            const float t = (P[row * 4 + 0] + P[row * 4 + 1]) + (P[row * 4 + 2] + P[row * 4 + 3]);
            __hip_atomic_store(xslot + ((size_t)(u.pm * 256 + row) * 4 + u.pn), t, __ATOMIC_RELAXED, __HIP_MEMORY_SCOPE_AGENT);
        }
        asm volatile("s_waitcnt vmcnt(0)" ::: "memory");
        if (lane == 0) __hip_atomic_fetch_add(cnt + 64 * u.pm, 1u, __ATOMIC_RELAXED, __HIP_MEMORY_SCOPE_AGENT);
        if (wid == 0) {
            unsigned sp = 0;
            while ((unsigned)__builtin_amdgcn_readfirstlane(__hip_atomic_load(cnt + 64 * u.pm, __ATOMIC_RELAXED, __HIP_MEMORY_SCOPE_AGENT)) < 32u) { __builtin_amdgcn_s_sleep(2); if (++sp > (1u << 20)) break; }
            __builtin_amdgcn_fence(__ATOMIC_ACQUIRE, "agent");
        }
        asm volatile("s_waitcnt vmcnt(0) lgkmcnt(0)" ::: "memory");
        __syncthreads();
        if (lane < 32) {
            const float* sl = xslot + (size_t)(u.pm * 256 + row) * 4; float t = 0.f;
#pragma unroll
            for (int q = 0; q < 4; ++q) t += __hip_atomic_load(sl + q, __ATOMIC_RELAXED, __HIP_MEMORY_SCOPE_AGENT);
            S[row] = rsqrtf(t * (1.0f / D) + EPS);
        }
        __syncthreads();
        f32x4 gv[2][2];
#pragma unroll
        for (int bj = 0; bj < 2; ++bj) { const int col0 = u.pn * 256 + bj * 128 + wc * 32 + fq * 8; gv[bj][0] = *(const f32x4*)(gfin + col0); gv[bj][1] = *(const f32x4*)(gfin + col0 + 4); }
#pragma unroll
        for (int ai = 0; ai < 2; ++ai)
#pragma unroll
            for (int m = 0; m < 4; ++m) {
                const int r = ai * 128 + wr * 64 + m * 16 + fr; const size_t row2 = (size_t)u.pm * 256 + r; const float rs = S[r];
#pragma unroll
                for (int bj = 0; bj < 2; ++bj) {
                    const int col0 = u.pn * 256 + bj * 128 + wc * 32 + fq * 8;
                    *(f32x4*)(out + row2 * D + col0) = acc[ai][bj][m][0] * rs * gv[bj][0]; *(f32x4*)(out + row2 * D + col0 + 4) = acc[ai][bj][m][1] * rs * gv[bj][1];
                }
            }
    }
};

#define XB_TMO      128
#define XB_XCNT(j)  (256  + 64 * (j))
#define XB_XSUB(j)  (1280 + 64 * (j))
#define XB_XGEN(j)  (2304 + 64 * (j))
#define XB_TOP      3328
#define XB_TOPGEN   3392
#define XCD_BAR_WORDS 3456
#define XB_SPIN_CAP (1u << 18)

__device__ __forceinline__ unsigned xb_ld(unsigned* p)              { return __hip_atomic_load(p, __ATOMIC_RELAXED, __HIP_MEMORY_SCOPE_AGENT); }
__device__ __forceinline__ unsigned xb_add(unsigned* p, unsigned v) { return __hip_atomic_fetch_add(p, v, __ATOMIC_RELAXED, __HIP_MEMORY_SCOPE_AGENT); }
__device__ __forceinline__ unsigned xb_xcc_id() { return (unsigned)__builtin_amdgcn_s_getreg((3 << 11) | 20) & 0xFu; }
#define XB_SPIN(cond, bar) do { unsigned _sp = 0; while (cond) { __builtin_amdgcn_s_sleep(1); \
    if ((++_sp & 255u) == 0u) { if (xb_ld(&(bar)[XB_TMO])) break; if (_sp > XB_SPIN_CAP) { atomicAdd(&(bar)[XB_TMO], 1u); break; } } } } while (0)

struct XcdBarrier {
    unsigned* bar; unsigned x;
    volatile LAS unsigned* st;
};

__device__ __forceinline__ XcdBarrier xcd_barrier_post(unsigned* bar, volatile LAS unsigned* st) {
    XcdBarrier b; b.bar = bar; b.x = xb_xcc_id(); b.st = st;
    if (threadIdx.x == 0) (void)xb_add(&bar[XB_XCNT(b.x)], 1u);
    return b;
}
__device__ __forceinline__ void xcd_barrier_complete(unsigned* bar, unsigned x, unsigned& nloc, unsigned& nx) {
    const unsigned G = gridDim.x * gridDim.y * gridDim.z;
    unsigned sum, cnt, mine, sp = 0u;
    for (;;) {
        sum = 0u; cnt = 0u; mine = 0u;
#pragma unroll
        for (unsigned j = 0; j < 16; ++j) { const unsigned c = xb_ld(&bar[XB_XCNT(j)]); sum += c; cnt += (c > 0u) ? 1u : 0u; mine = (j == x) ? c : mine; }
        if (sum == G) break;
        __builtin_amdgcn_s_sleep(1);
        if ((++sp & 255u) == 0u) { if (xb_ld(&bar[XB_TMO])) break; if (sp > XB_SPIN_CAP) { atomicAdd(&bar[XB_TMO], 1u); break; } }
    }
    nloc = mine > 0u ? mine : 1u; nx = cnt > 0u ? cnt : 1u;
}

__device__ __forceinline__ void xcd_barrier(const XcdBarrier& b) {
    asm volatile("s_waitcnt vmcnt(0)" ::: "memory");
    __syncthreads();
    if (threadIdx.x == 0) {
        unsigned* bar = b.bar;
        __builtin_amdgcn_s_waitcnt(0);
        unsigned nloc = b.st[0], nx = b.st[1];
        if (nloc == 0u) { xcd_barrier_complete(bar, b.x, nloc, nx); b.st[0] = nloc; b.st[1] = nx; }
        const unsigned old = xb_add(&bar[XB_XSUB(b.x)], 1u);
        const unsigned gen = old / nloc;
        if (old + 1u == (gen + 1u) * nloc) {
            __builtin_amdgcn_fence(__ATOMIC_RELEASE, "agent");
            asm volatile("s_waitcnt vmcnt(0)" ::: "memory");
            const unsigned og = xb_add(&bar[XB_TOP], 1u);
            const unsigned tg = og / nx;
            if (og + 1u == (tg + 1u) * nx) xb_add(&bar[XB_TOPGEN], 1u);
            else XB_SPIN(xb_ld(&bar[XB_TOPGEN]) == tg, bar);
            __builtin_amdgcn_fence(__ATOMIC_ACQUIRE, "agent");
            xb_add(&bar[XB_XGEN(b.x)], 1u);
            asm volatile("s_waitcnt vmcnt(0)" ::: "memory");
        } else {
            XB_SPIN(xb_ld(&bar[XB_XGEN(b.x)]) == gen, bar);
            __builtin_amdgcn_fence(__ATOMIC_ACQUIRE, "agent");
            asm volatile("s_waitcnt vmcnt(0)" ::: "memory");
        }
    }
    __syncthreads();
}


struct DepOrder : pg8::StaticOrder {
    unsigned* wait_ctr; unsigned wait_need; int wait_pm; unsigned* done_ctr; int done_pm;
    bool done_rel = true;
    int rot = 0;
    __device__ __forceinline__ bool next(int i, Unit& u) const {
        const int span = lim - L_off, n_c = span / G + (c < span % G ? 1 : 0); if (i >= n_c) return false;
        return pg8::StaticOrder::next(rot ? (i + rot) % n_c : i, u);
    }
    __device__ __forceinline__ void a_ready(const Unit& u) const {
        if (wait_pm == -2 || (wait_pm >= 0 && u.pm != wait_pm)) return;
        if (threadIdx.x < 64) {
            unsigned sp = 0;
            while ((unsigned)__builtin_amdgcn_readfirstlane(__hip_atomic_load(wait_ctr, __ATOMIC_RELAXED, __HIP_MEMORY_SCOPE_AGENT)) < wait_need) { __builtin_amdgcn_s_sleep(2); if (++sp > (1u << 21)) break; }
            __builtin_amdgcn_fence(__ATOMIC_ACQUIRE, "agent");
            asm volatile("s_waitcnt vmcnt(0)" ::: "memory");
        }
        asm volatile("" ::: "memory"); __builtin_amdgcn_s_barrier(); asm volatile("" ::: "memory");
    }
    __device__ __forceinline__ void done(const Unit& u) const {
        if (done_pm == -2 || (done_pm >= 0 && u.pm != done_pm)) return;
        asm volatile("s_waitcnt vmcnt(0)" ::: "memory");
        asm volatile("" ::: "memory"); __builtin_amdgcn_s_barrier(); asm volatile("" ::: "memory");
        if (threadIdx.x < 64) {
            if (done_rel) { __builtin_amdgcn_fence(__ATOMIC_RELEASE, "agent"); asm volatile("s_waitcnt vmcnt(0)" ::: "memory"); }
            if (threadIdx.x == 0) __hip_atomic_fetch_add(done_ctr, 1u, __ATOMIC_RELAXED, __HIP_MEMORY_SCOPE_AGENT);
        }
    }
};

struct Args { const float* in[26]; float* out; unsigned char* ws; };

typedef const __attribute__((address_space(4))) Args* KArgs;
__device__ __forceinline__ KArgs kargs() { KArgs p = (KArgs)__builtin_amdgcn_kernarg_segment_ptr(); asm volatile("" : "+s"(p)); return p; }
#define KIN(i) ((const float*)k->in[i])
#define WSP(T, off) ((T*)(k->ws + (off)))
__device__ __forceinline__ f32x2 cmul(f32x2 a, f32x2 b) { return (f32x2){a.x * b.x - a.y * b.y, a.x * b.y + a.y * b.x}; }
__device__ __forceinline__ f32x2 cexp_(float re, float im) { float s, c; sincosf(im, &s, &c); const float e = expf(re); return (f32x2){e * c, e * s}; }
__device__ __forceinline__ f32x2 zoh_coef(float are, float aim, float dt) {
    const f32x2 ab = cexp_(dt * are, dt * aim); const float nr = ab.x - 1.0f, ni = ab.y, den = 1.0f / (are * are + aim * aim);
    return (f32x2){(nr * are + ni * aim) * den, (ni * are - nr * aim) * den};
}

__device__ __forceinline__ void transpose_item(const float* W, int N, bf16* WT, int ldt, int k0, int n0, int src_n0, const float* gk, LAS float* scr, int lane) {
    float wv[32];
#pragma unroll
    for (int i = 0; i < 32; ++i) { const int kk = 2 * i + (lane >> 5); wv[i] = W[(size_t)(k0 + kk) * N + src_n0 + (lane & 31)]; }
    if (gk) {
#pragma unroll
        for (int i = 0; i < 32; ++i) wv[i] *= gk[k0 + 2 * i + (lane >> 5)];
    }
#pragma unroll
    for (int i = 0; i < 32; ++i) scr[(2 * i + (lane >> 5)) * 33 + (lane & 31)] = wv[i];
    LDS_WAIT(); asm volatile("" ::: "memory");
    const int c = lane & 7;
#pragma unroll
    for (int j = 0; j < 4; ++j) { const int n = (lane >> 3) + 8 * j; const LAS float* s = scr + (8 * c) * 33 + n;
        v4u o; o.x = cvt_pk_bf16(s[0 * 33], s[1 * 33]); o.y = cvt_pk_bf16(s[2 * 33], s[3 * 33]); o.z = cvt_pk_bf16(s[4 * 33], s[5 * 33]); o.w = cvt_pk_bf16(s[6 * 33], s[7 * 33]);
        *(v4u*)(WT + (size_t)(n0 + n) * ldt + k0 + 8 * c) = o; }
    LDS_WAIT(); asm volatile("" ::: "memory");
}

__global__ void __launch_bounds__(512, 2) fwd_kernel(Args a) {
    extern __shared__ __attribute__((aligned(16))) unsigned char lds_raw[];
    LAS unsigned char* lds = (LAS unsigned char*)lds_raw;
    cg::grid_group grid = cg::this_grid();
    const int tid = threadIdx.x, lane = tid & 63, wave = __builtin_amdgcn_readfirstlane(tid >> 6);
    const int G = gridDim.x, bx = blockIdx.x;
    const int gw = bx * 8 + wave, NGW = G * 8;
    const size_t gt = (size_t)bx * 512 + tid, NGT = (size_t)G * 512;
    volatile LAS unsigned* MISC = (volatile LAS unsigned*)(lds + 131072 + 1024);
    if (tid < 16) MISC[tid] = 0u;
    __syncthreads();
    XcdBarrier xbar;
    { KArgs k = kargs(); if (k->ws == nullptr) grid.sync();
      xbar = xcd_barrier_post((unsigned*)(k->ws + WS_BAR), MISC + 8); }

    {
        KArgs k = kargs();
        const float* x_p = KIN(0); const float* x_s = KIN(1); const float* g_mix = KIN(6); const float* w_in = KIN(7); const float* a_re = KIN(8); const float* a_im = KIN(9); const float* log_dt = KIN(10);
        const float* b_re = KIN(11); const float* b_im = KIN(12); const float* w_glu = KIN(16);
        bf16* WIN = WSP(bf16, WS_WIN); bf16* WGLU = WSP(bf16, WS_WGLU); unsigned* CTR = WSP(unsigned, WS_CTR);
        f32x2* ABAR = WSP(f32x2, WS_ABAR); f32x2* AT = WSP(f32x2, WS_AT); f32x2* BBAR = WSP(f32x2, WS_BBAR); f32x2* APW = WSP(f32x2, WS_APW);
        float* SS = WSP(float, WS_SS); bf16* XN = WSP(bf16, WS_XN); float* RINV = WSP(float, WS_RINV);
        {
            LAS float* scr = (LAS float*)(lds + wave * 16384);
            constexpr int I_IN = 16 * 32, I_GLU = 8 * 16;
            for (int it = gw; it < I_IN + I_GLU; it += NGW) {
                int r = it;
                if (r < I_IN) { const int kb = r / 32, nb = r % 32; transpose_item(w_in, D, WIN, D, 64 * kb, 32 * nb, 32 * nb, nullptr, scr, lane); continue; } r -= I_IN;
                { const int kb = r / 16, nb = r % 16; transpose_item(w_glu, 512, WGLU, 512, 64 * kb, 32 * nb, 32 * nb, nullptr, scr, lane); }
            }
        }
        auto xn_rows2 = [&](int m) {
            v2u* o8 = (v2u*)(XN + (size_t)m * D) + lane;
            if (m < MTOT) {
                const float* xr = m < MP ? x_p + (size_t)m * D : x_s + (size_t)(m - MP) * D;
                const f32x4* xr4 = (const f32x4*)xr + lane;
                f32x4 v[2][4]; float sq0 = 0.f, sq1 = 0.f;
#pragma unroll
                for (int j = 0; j < 4; ++j) { v[0][j] = __builtin_nontemporal_load(xr4 + 64 * j); v[1][j] = __builtin_nontemporal_load(xr4 + 256 + 64 * j); }
#pragma unroll
                for (int j = 0; j < 4; ++j) { sq0 += (v[0][j][0] * v[0][j][0] + v[0][j][1] * v[0][j][1]) + (v[0][j][2] * v[0][j][2] + v[0][j][3] * v[0][j][3]);
                                              sq1 += (v[1][j][0] * v[1][j][0] + v[1][j][1] * v[1][j][1]) + (v[1][j][2] * v[1][j][2] + v[1][j][3] * v[1][j][3]); }
                const float ms0 = wave_sum(sq0) * (1.0f / D) + EPS, ms1 = wave_sum(sq1) * (1.0f / D) + EPS; const float rs0 = rsqrtf(ms0), rs1 = rsqrtf(ms1);
                if (lane == 0) { RINV[m] = sqrtf(ms0); RINV[m + 1] = sqrtf(ms1); }
#pragma unroll
                for (int j = 0; j < 4; ++j) { const f32x4 gq = ((const f32x4*)g_mix)[lane + 64 * j]; const f32x4 y0 = v[0][j] * rs0 * gq, y1 = v[1][j] * rs1 * gq;
                    v2u w; w.x = cvt_pk_bf16(y0[0], y0[1]); w.y = cvt_pk_bf16(y0[2], y0[3]); o8[64 * j] = w;
                    v2u w1; w1.x = cvt_pk_bf16(y1[0], y1[1]); w1.y = cvt_pk_bf16(y1[2], y1[3]); o8[256 + 64 * j] = w1; }
            } else {
#pragma unroll
                for (int j = 0; j < 4; ++j) { o8[64 * j] = (v2u){0u, 0u}; o8[256 + 64 * j] = (v2u){0u, 0u}; }
            }
        };
        auto xn_row1 = [&](int m) {
            v2u* o8 = (v2u*)(XN + (size_t)m * D) + lane;
            if (m < MTOT) {
                const float* xr = m < MP ? x_p + (size_t)m * D : x_s + (size_t)(m - MP) * D;
                const f32x4* xr4 = (const f32x4*)xr + lane;
                f32x4 v[4]; float sq = 0.f;
#pragma unroll
                for (int j = 0; j < 4; ++j) v[j] = xr4[64 * j];
#pragma unroll
                for (int j = 0; j < 4; ++j) sq += (v[j][0] * v[j][0] + v[j][1] * v[j][1]) + (v[j][2] * v[j][2] + v[j][3] * v[j][3]);
                const float ms = wave_sum(sq) * (1.0f / D) + EPS; const float rs = rsqrtf(ms);
                if (lane == 0) RINV[m] = sqrtf(ms);
#pragma unroll
                for (int j = 0; j < 4; ++j) { const f32x4 gq = ((const f32x4*)g_mix)[lane + 64 * j]; const f32x4 y = v[j] * rs * gq;
                    v2u w; w.x = cvt_pk_bf16(y[0], y[1]); w.y = cvt_pk_bf16(y[2], y[3]); o8[64 * j] = w; }
            } else {
#pragma unroll
                for (int j = 0; j < 4; ++j) o8[64 * j] = (v2u){0u, 0u};
            }
        };
        {
            for (size_t i = gt; i < (size_t)MPAD; i += NGT) SS[i] = 0.f;
            for (int it = bx; it * 8 < NG * NP; it += G) if (tid < 8) {
                const size_t i = (size_t)it * 8 + tid;
                const int g = (int)i / NP; const float dt = expf(log_dt[g]); const float are = a_re[i], aim = a_im[i];
                f32x4 br[4], bi[4];
#pragma unroll
                for (int q = 0; q < 4; ++q) { br[q] = *(const f32x4*)(b_re + i * NH + 4 * q); bi[q] = *(const f32x4*)(b_im + i * NH + 4 * q); }
                const f32x2 ab = cexp_(dt * are, dt * aim); f32x2 pw = (f32x2){1.f, 0.f};
#pragma unroll
                for (int q = 0; q <= 16; ++q) { APW[i * 17 + q] = pw; if (q == 16) AT[i] = pw; pw = cmul(pw, ab); }
                ABAR[i] = ab;
                const float nr = ab.x - 1.0f, ni = ab.y, den = 1.0f / (are * are + aim * aim);
                const f32x2 cf = (f32x2){(nr * are + ni * aim) * den, (ni * are - nr * aim) * den};
#pragma unroll
                for (int h = 0; h < NH; ++h) BBAR[i * NH + h] = cmul(cf, (f32x2){br[h >> 2][h & 3], bi[h >> 2][h & 3]});
            }
            for (int m = 2 * gw; m < MP; m += 2 * NGW) xn_rows2(m);
            if (wave == 7) for (int m = MP + bx; m < MPAD; m += G) xn_row1(m);
        }
    }
    xcd_barrier(xbar);

    {
        KArgs k = kargs();
        bf16* XN = WSP(bf16, WS_XN); bf16* WIN = WSP(bf16, WS_WIN); bf16* UPERM = WSP(bf16, WS_UPERM); float* USAMP = WSP(float, WS_USAMP); float* V = WSP(float, WS_V);
        pg8::Gemm g{XN, WIN, MP, D, D, D}; pg8::StaticOrder S; S.init(MP, D, G, bx);
        EpiProj Ep{UPERM, USAMP, V};
        pg8::gemm_phase<EpiProj, pg8::StaticOrder, true, true, 0>(lds, g, S, Ep);
    }
    if (bx < 64) {
        KArgs k = kargs();
        const bf16* XN = WSP(bf16, WS_XN); const bf16* WIN = WSP(bf16, WS_WIN); float* USAMP = WSP(float, WS_USAMP); float* V = WSP(float, WS_V);
        const int r16 = lane & 15, q4 = lane >> 4;
        f32x4 pa[8];
#pragma unroll
        for (int rbk = 0; rbk < 8; ++rbk) pa[rbk] = (f32x4){0.f, 0.f, 0.f, 0.f};
        const bf16* wp = WIN + ((size_t)(16 * bx + r16) * D + 128 * wave + 8 * q4);
        const bf16* ap = XN + ((size_t)(MP + r16) * D + 128 * wave + 8 * q4);
#pragma unroll
        for (int ks = 0; ks < 4; ++ks) {
            const bf16x8 wf = *(const bf16x8*)(wp + 32 * ks);
#pragma unroll
            for (int rbk = 0; rbk < 8; ++rbk) { const bf16x8 af = *(const bf16x8*)(ap + (size_t)rbk * 16 * D + 32 * ks); pa[rbk] = __builtin_amdgcn_mfma_f32_16x16x32_bf16(wf, af, pa[rbk], 0, 0, 0); }
        }
        LAS f32x4* red = (LAS f32x4*)lds;
#pragma unroll
        for (int rbk = 0; rbk < 8; ++rbk) red[(wave * 8 + rbk) * 64 + lane] = pa[rbk];
        __syncthreads();
        f32x4 t = (f32x4){0.f, 0.f, 0.f, 0.f};
#pragma unroll
        for (int w2 = 0; w2 < 8; ++w2) t += red[(w2 * 8 + wave) * 64 + lane];
        const int ns = 16 * wave + r16, col = 16 * bx + 4 * q4;
        if (col < 512) *(f32x4*)(USAMP + (size_t)ns * 512 + col) = t; else *(f32x4*)(V + (size_t)(MP + ns) * 512 + (col - 512)) = t;
        __syncthreads();
    } else
    {
        KArgs k = kargs();
        const float* c_re = KIN(13); const float* c_im = KIN(14); const float* s5_d = KIN(15);
        bf16* KTAB = WSP(bf16, WS_KTAB); bf16* W2 = WSP(bf16, WS_W2); bf16* W3 = WSP(bf16, WS_W3); const f32x2* BBAR = WSP(f32x2, WS_BBAR); const f32x2* APW = WSP(f32x2, WS_APW);
        const size_t vt = (size_t)(bx - 64) * 512 + tid, VNT = (size_t)(G - 64) * 512;
        for (size_t i = vt; i < (size_t)NG * 16 * 64; i += VNT) {
            const int hq = (int)i & 3, h = ((int)i >> 2) & 15, lag = ((int)i >> 6) & 15, g = (int)i >> 10;
            float s0 = 0.f, s1 = 0.f, s2 = 0.f, s3 = 0.f;
            const float* crp = c_re + (size_t)(g * NH + h) * NP; const float* cip = c_im + (size_t)(g * NH + h) * NP;
#pragma unroll 8
            for (int p = 0; p < NP; ++p) {
                const int gp = g * NP + p;
                const f32x2 ac = cmul(APW[gp * 17 + lag], (f32x2){crp[p], cip[p]});
                const f32x4 b01 = *(const f32x4*)(BBAR + (size_t)gp * NH + 4 * hq), b23 = *(const f32x4*)(BBAR + (size_t)gp * NH + 4 * hq + 2);
                s0 += ac.x * b01[0] - ac.y * b01[1]; s1 += ac.x * b01[2] - ac.y * b01[3]; s2 += ac.x * b23[0] - ac.y * b23[1]; s3 += ac.x * b23[2] - ac.y * b23[3];
            }
            if (lag == 0 && (h >> 2) == hq) { const float dd = s5_d[g * NH + h]; if ((h & 3) == 0) s0 += dd; else if ((h & 3) == 1) s1 += dd; else if ((h & 3) == 2) s2 += dd; else s3 += dd; }
            v2u w; w.x = cvt_pk_bf16(s0, s1); w.y = cvt_pk_bf16(s2, s3);
            *(v2u*)(KTAB + i * 4) = w;
        }
        for (size_t i = vt; i < (size_t)NG * NP * 16; i += VNT) {
            const int j = (int)i & 15, p = ((int)i >> 4) & 63, g = (int)i >> 10; const int gp = g * NP + p;
            const f32x2 cf = APW[gp * 17 + 15 - j];
            unsigned wre[8], wim[8];
#pragma unroll
            for (int h = 0; h < NH; h += 2) {
                const f32x4 b2 = *(const f32x4*)(BBAR + (size_t)gp * NH + h);
                const f32x2 v0 = cmul(cf, (f32x2){b2[0], b2[1]}), v1 = cmul(cf, (f32x2){b2[2], b2[3]});
                wre[h >> 1] = cvt_pk_bf16(v0.x, v1.x); wim[h >> 1] = cvt_pk_bf16(v0.y, v1.y);
            }
            bf16* w2r = W2 + ((size_t)(g * 128 + 2 * p) * 256 + j * 16);
            *(v4u*)(w2r) = (v4u){wre[0], wre[1], wre[2], wre[3]}; *(v4u*)(w2r + 8) = (v4u){wre[4], wre[5], wre[6], wre[7]};
            *(v4u*)(w2r + 256) = (v4u){wim[0], wim[1], wim[2], wim[3]}; *(v4u*)(w2r + 264) = (v4u){wim[4], wim[5], wim[6], wim[7]};
        }
        for (size_t i = vt; i < (size_t)NG * 16 * 16 * 16; i += VNT) {
            const int pq = (int)i & 15, h = ((int)i >> 4) & 15, j = ((int)i >> 8) & 15, g = (int)i >> 12;
            const f32x4 cr4 = *(const f32x4*)(c_re + (size_t)(g * NH + h) * NP + 4 * pq), ci4 = *(const f32x4*)(c_im + (size_t)(g * NH + h) * NP + 4 * pq);
            unsigned w[4];
#pragma unroll
            for (int q = 0; q < 4; ++q) { const f32x2 v = cmul(APW[(g * NP + 4 * pq + q) * 17 + j + 1], (f32x2){cr4[q], ci4[q]}); w[q] = cvt_pk_bf16(v.x, -v.y); }
            *(v4u*)(W3 + ((size_t)(g * 256 + j * 16 + h) * 128 + 8 * pq)) = (v4u){w[0], w[1], w[2], w[3]};
        }
    }
    xcd_barrier(xbar);

    {
        KArgs k = kargs();
        float* out = k->out;
        const bf16* UPERM = WSP(bf16, WS_UPERM); const bf16* W2 = WSP(bf16, WS_W2); const bf16* KTAB = WSP(bf16, WS_KTAB); const bf16* W3 = WSP(bf16, WS_W3); bf16* YG = WSP(bf16, WS_YG);
        const f32x2* AT = WSP(f32x2, WS_AT);
        const int r16 = lane & 15, q4 = lane >> 4;
        LAS unsigned char* EbB = lds;
        LAS unsigned char* W2S = lds + 65536;
        LAS unsigned char* W3S = lds;
        LAS bf16* hl = (LAS bf16*)(lds + 69632 + wave * 4352);
        LAS bf16* ktl = (LAS bf16*)(lds + 133120);
        for (int task = bx; task < NG * NB; task += G) {
            const int g = task >> 3, nb = task & 7, rb = nb * 8 + wave, c0 = 16 * wave;
            const bf16* up = UPERM + ((size_t)(g * NROW + rb * 16 + r16) * 256 + 8 * q4);
            *(LAS v4u*)(ktl + tid * 8) = *(const v4u*)(KTAB + (size_t)g * 4096 + tid * 8);
            {
                const bf16* w2g = W2 + (size_t)g * 128 * 256;
                v4u tv[8];
#pragma unroll
                for (int ii = 0; ii < 8; ++ii) tv[ii] = *(const v4u*)(w2g + (size_t)(tid + 512 * ii) * 8);
#pragma unroll
                for (int ii = 0; ii < 8; ++ii) { const int idx = tid + 512 * ii, q = idx >> 5, c16 = idx & 31; *(LAS v4u*)(W2S + q * 512 + ((c16 ^ (q & 15)) << 4)) = tv[ii]; }
            }
            __syncthreads();
            {
                f32x4 ea[8];
#pragma unroll
                for (int cb = 0; cb < 8; ++cb) ea[cb] = (f32x4){0.f, 0.f, 0.f, 0.f};
                bf16x8 ufr[8];
#pragma unroll
                for (int ks = 0; ks < 8; ++ks) ufr[ks] = *(const bf16x8*)(up + 32 * ks);
#pragma unroll
                for (int ks = 0; ks < 8; ++ks)
#pragma unroll
                    for (int cb = 0; cb < 8; ++cb) { const bf16x8 wf = *(const LAS bf16x8*)(W2S + (cb * 16 + r16) * 512 + (((4 * ks + q4) ^ r16) << 4)); ea[cb] = __builtin_amdgcn_mfma_f32_16x16x32_bf16(wf, ufr[ks], ea[cb], 0, 0, 0); }
#pragma unroll
                for (int cb = 0; cb < 8; ++cb) *(LAS f32x4*)(EbB + (c0 + r16) * 512 + (((4 * cb + q4) ^ r16) << 4)) = ea[cb];
            }
            __syncthreads();
            {
                const f32x2 aT = AT[g * NP + lane]; f32x2 S = (f32x2){0.f, 0.f};
                const int ch = lane >> 1, wo = (lane & 1) * 8;
                for (int c = 0; c < c0; c += 16) {
                    f32x2 ev[16];
#pragma unroll
                    for (int q = 0; q < 16; ++q) ev[q] = *(const LAS f32x2*)(EbB + (c + q) * 512 + ((ch ^ q) << 4) + wo);
#pragma unroll
                    for (int q = 0; q < 16; ++q) S = cmul(aT, S) + ev[q];
                }
#pragma unroll
                for (int cc = 0; cc < 16; ++cc) {
                    *(LAS unsigned*)(hl + cc * 136 + 2 * lane) = cvt_pk_bf16(S.x, S.y);
                    const f32x2 e = *(const LAS f32x2*)(EbB + (c0 + cc) * 512 + ((ch ^ cc) << 4) + wo); S = cmul(aT, S) + e;
                }
                if (wave == 7) { out[O_PRE + (size_t)nb * 2048 + g * NP + lane] = S.x; out[O_PIM + (size_t)nb * 2048 + g * NP + lane] = S.y; }
            }
            __syncthreads();
            {
                const bf16* w3g = W3 + (size_t)g * 256 * 128;
                v4u tv[8];
#pragma unroll
                for (int ii = 0; ii < 8; ++ii) tv[ii] = *(const v4u*)(w3g + (size_t)(tid + 512 * ii) * 8);
#pragma unroll
                for (int ii = 0; ii < 8; ++ii) { const int idx = tid + 512 * ii, jr = idx >> 4, c16 = idx & 15; *(LAS v4u*)(W3S + jr * 256 + ((c16 ^ (jr & 15)) << 4)) = tv[ii]; }
            }
            f32x4 acc[16];
#pragma unroll
            for (int cb = 0; cb < 16; ++cb) acc[cb] = (f32x4){0.f, 0.f, 0.f, 0.f};
            const LAS bf16* kt2 = ktl + (r16 * 16 + 8 * (q4 & 1)) - (q4 >> 1) * 256;
#pragma unroll
            for (int kr = 0; kr < 4; ++kr) {
                bf16x8 ufr[2], wfr[2][16];
#pragma unroll
                for (int kk = 0; kk < 2; ++kk) { const int ks = 2 * kr + kk; ufr[kk] = *(const bf16x8*)(up + 32 * ks);
#pragma unroll
                    for (int cb = 0; cb < 16; ++cb) if (2 * ks <= cb) {
                        wfr[kk][cb] = *(const LAS bf16x8*)(kt2 + (cb - 2 * ks) * 256);
                        if (cb == 2 * ks && (q4 >> 1)) wfr[kk][cb] = (bf16x8){0, 0, 0, 0, 0, 0, 0, 0};
                    } }
#pragma unroll
                for (int kk = 0; kk < 2; ++kk) { const int ks = 2 * kr + kk;
#pragma unroll
                    for (int cb = 0; cb < 16; ++cb) if (2 * ks <= cb) acc[cb] = __builtin_amdgcn_mfma_f32_16x16x32_bf16(wfr[kk][cb], ufr[kk], acc[cb], 0, 0, 0); }
                asm volatile("" ::: "memory");
            }
            __syncthreads();
#pragma unroll
            for (int ks = 0; ks < 4; ++ks) {
                const bf16x8 hf = *(const LAS bf16x8*)(hl + r16 * 136 + 32 * ks + 8 * q4);
#pragma unroll
                for (int cb = 0; cb < 16; ++cb) { const bf16x8 wf = *(const LAS bf16x8*)(W3S + (cb * 16 + r16) * 256 + (((4 * ks + q4) ^ r16) << 4)); acc[cb] = __builtin_amdgcn_mfma_f32_16x16x32_bf16(wf, hf, acc[cb], 0, 0, 0); }
            }
            const int row = rb * 16 + r16, c = row & 127;
            bf16* yp = YG + ((size_t)(nb * L + c * 16) * 512 + g * 16 + 4 * q4);
#pragma unroll
            for (int cb = 0; cb < 16; ++cb) {
                const f32x4 y = gelu4(acc[cb]);
                v2u wv; wv.x = cvt_pk_bf16(y[0], y[1]); wv.y = cvt_pk_bf16(y[2], y[3]);
                *(v2u*)(yp + (size_t)cb * 512) = wv;
            }
            __syncthreads();
        }
    }
    {
        KArgs k = kargs();
        float* out = k->out; const float* V = WSP(float, WS_V); bf16* AMIX = WSP(bf16, WS_AMIX); bf16* YG = WSP(bf16, WS_YG);
        for (size_t i = gt; i < (size_t)(MP / 8) * 128; i += NGT) {
            const int rb8 = (int)(i >> 7), c4 = (int)(i & 127) * 4, gi = c4 >> 7, w = 2 << gi;
            const int row0 = rb8 * 8, tl0 = row0 & (L - 1);
            const float* vp = V + (size_t)row0 * 512 + c4;
            f32x4 r[23];
#pragma unroll
            for (int j = 0; j < 23; ++j) { r[j] = (f32x4){0.f, 0.f, 0.f, 0.f}; if (tl0 + j - 15 >= 0) r[j] = *(const f32x4*)(vp + (ptrdiff_t)(j - 15) * 512); }
#pragma unroll
            for (int j = 0; j < 8; ++j) {
                const int tl = tl0 + j; const int cnt = (tl + 1) < w ? (tl + 1) : w;
                f32x4 sm = r[15 + j];
#pragma unroll
                for (int q = 1; q < 16; ++q) if (q < w) sm += r[15 + j - q];
                const f32x4 o = sm * (1.0f / (float)cnt) - r[15 + j];
                if (tl >= L - 15) *(f32x4*)(out + O_PPOOL + ((size_t)(((row0 + j) >> 11) * 15 + (tl - (L - 15))) * 512 + c4)) = r[15 + j];
                v2u wv; wv.x = cvt_pk_bf16(o[0], o[1]); wv.y = cvt_pk_bf16(o[2], o[3]);
                *(v2u*)(AMIX + (size_t)(row0 + j) * D + 512 + c4) = wv;
            }
        }
        for (size_t i = gt; i < (size_t)(MPAD - MTOT) * 512 / 8; i += NGT) *(v4u*)(YG + (size_t)MTOT * 512 + i * 8) = (v4u){0u, 0u, 0u, 0u};
        {
            const float* g_ffn = KIN(20); const float* w_up = KIN(21); bf16* WUP = WSP(bf16, WS_WUP);
            LAS float* scr = (LAS float*)(lds + wave * 16384);
            for (int r = gw; r < 16 * 176; r += NGW) { const int kb = r / 176, nb = r % 176; const int n0 = 32 * nb, pn = n0 >> 8, lr = n0 & 255; const int src = lr < 128 ? 128 * pn + lr : FF + 128 * pn + (lr - 128);
                transpose_item(w_up, FF2, WUP, D, 64 * kb, n0, src, g_ffn, scr, lane); }
        }
    }
    {
        KArgs k = kargs();
        float* out = k->out; const float* st_re = KIN(2); const float* st_im = KIN(3); const float* st_pool = KIN(4); const float* c_re = KIN(13); const float* c_im = KIN(14); const float* s5_d = KIN(15);
        const float* V = WSP(float, WS_V); bf16* AMIX = WSP(bf16, WS_AMIX); const float* USAMP = WSP(float, WS_USAMP); const f32x2* ABAR = WSP(f32x2, WS_ABAR); const f32x2* BBAR = WSP(f32x2, WS_BBAR); bf16* YG = WSP(bf16, WS_YG);
        for (int task = gw; task < NS * NG; task += NGW) {
            const int ns = task >> 5, g = task & 31; const int gp = g * NP + lane;
            const float* ur = USAMP + (size_t)ns * 512 + g * 16;
            float uu[NH];
#pragma unroll
            for (int h = 0; h < NH; ++h) uu[h] = ur[h];
            f32x2 bu = (f32x2){0.f, 0.f};
#pragma unroll
            for (int h = 0; h < NH; ++h) { const f32x2 bb = BBAR[(size_t)gp * NH + h]; bu.x += bb.x * uu[h]; bu.y += bb.y * uu[h]; }
            const f32x2 h0 = (f32x2){st_re[(size_t)ns * 2048 + gp], st_im[(size_t)ns * 2048 + gp]};
            const f32x2 hn = cmul(ABAR[gp], h0) + bu;
            out[O_SRE + (size_t)ns * 2048 + gp] = hn.x; out[O_SIM + (size_t)ns * 2048 + gp] = hn.y;
            float cr[NH], ci[NH];
#pragma unroll
            for (int h = 0; h < NH; ++h) { cr[h] = c_re[(size_t)(g * NH + h) * NP + lane]; ci[h] = c_im[(size_t)(g * NH + h) * NP + lane]; }
            float t[NH];
#pragma unroll
            for (int h = 0; h < NH; ++h) t[h] = cr[h] * hn.x - ci[h] * hn.y;
            const bool b5 = (lane & 32) != 0, b4 = (lane & 16) != 0, b3 = (lane & 8) != 0, b2 = (lane & 4) != 0;
            float ra[8], rb[4], rc[2];
#pragma unroll
            for (int i = 0; i < 8; ++i) { const float keep = b5 ? t[i + 8] : t[i], send = b5 ? t[i] : t[i + 8]; ra[i] = keep + __shfl_xor(send, 32); }
#pragma unroll
            for (int i = 0; i < 4; ++i) { const float keep = b4 ? ra[i + 4] : ra[i], send = b4 ? ra[i] : ra[i + 4]; rb[i] = keep + __shfl_xor(send, 16); }
#pragma unroll
            for (int i = 0; i < 2; ++i) { const float keep = b3 ? rb[i + 2] : rb[i], send = b3 ? rb[i] : rb[i + 2]; rc[i] = keep + __shfl_xor(send, 8); }
            float rd; { const float keep = b2 ? rc[1] : rc[0], send = b2 ? rc[0] : rc[1]; rd = keep + __shfl_xor(send, 4); }
            rd += __shfl_xor(rd, 2); rd += __shfl_xor(rd, 1);
            const int hsel = (b5 ? 8 : 0) + (b4 ? 4 : 0) + (b3 ? 2 : 0) + (b2 ? 1 : 0);
            const float my = rd + s5_d[g * NH + hsel] * ur[hsel];
            if ((lane & 3) == 0) YG[(size_t)(MP + ns) * 512 + g * 16 + hsel] = (bf16)(cvt_pk_bf16(gelu_exact(my), 0.f) & 0xffffu);
        }
        for (size_t i = gt; i < (size_t)(MPAD - MP) * 128; i += NGT) {
            const int row = MP + (int)(i >> 7), c4 = (int)(i & 127) * 4, gi = c4 >> 7, w = 2 << gi;
            f32x4 o = (f32x4){0.f, 0.f, 0.f, 0.f};
            if (row < MTOT) {
                const int ns = row - MP;
                const f32x4 vt4 = *(const f32x4*)(V + (size_t)row * 512 + c4); f32x4 s = vt4;
                f32x4 bq[15];
#pragma unroll
                for (int q = 1; q < 16; ++q) bq[q - 1] = *(const f32x4*)(st_pool + ((size_t)(ns * 15 + 15 - q) * 512 + c4));
#pragma unroll
                for (int q = 1; q < 16; ++q) if (q < w) s += bq[q - 1];
                o = s * (1.0f / (float)w) - vt4;
                *(f32x4*)(out + O_SPOOL + ((size_t)(ns * 15 + 14) * 512 + c4)) = vt4;
#pragma unroll
                for (int r = 0; r < 14; ++r) *(f32x4*)(out + O_SPOOL + ((size_t)(ns * 15 + r) * 512 + c4)) = bq[13 - r];
            }
            v2u wv; wv.x = cvt_pk_bf16(o[0], o[1]); wv.y = cvt_pk_bf16(o[2], o[3]);
            *(v2u*)(AMIX + (size_t)row * D + 512 + c4) = wv;
        }
    }
    xcd_barrier(xbar);

    {
        KArgs k = kargs();
        bf16* YG = WSP(bf16, WS_YG); bf16* WGLU = WSP(bf16, WS_WGLU); bf16* AMIX = WSP(bf16, WS_AMIX);
        pg8::Gemm g{YG, WGLU, MPAD, 512, 512, 512}; pg8::StaticOrder S; S.init(MPAD, 512, G, bx);
        EpiGlu Ep{YG, AMIX};
        pg8::gemm_phase<EpiGlu, pg8::StaticOrder, true, true, 0>(lds, g, S, Ep);
    }
    if (bx >= 194) {
        KArgs k = kargs();
        const float* w_out = KIN(19); const float* w_down = KIN(24);
        bf16* WMIX = WSP(bf16, WS_WMIX); bf16* WDN = WSP(bf16, WS_WDN);
        const int vw = (bx - 194) * 8 + wave, VNW = (G - 194) * 8;
        LAS float* scr = (LAS float*)(lds + wave * 16384);
        constexpr int I_OUT = 8 * 32, I_DN = 44 * 32;
        for (int it = vw; it < I_OUT + I_DN; it += VNW) {
            int r = it;
            if (r < I_OUT) { const int kb = r / 32, nb = r % 32; transpose_item(w_out, D, WMIX, D, 64 * kb, 32 * nb, 32 * nb, nullptr, scr, lane); continue; } r -= I_OUT;
            { const int kb = r / 32, nb = r % 32; transpose_item(w_down, D, WDN, FF, 64 * kb, 32 * nb, 32 * nb, nullptr, scr, lane); }
        }
    } else if (bx >= 130) {
        KArgs k = kargs();
        const float* pool_w = KIN(17); const float* pool_scale = KIN(18); const float* w_out = KIN(19); bf16* WMIX = WSP(bf16, WS_WMIX);
        const size_t vt = (size_t)(bx - 130) * 512 + tid, VNT = (size_t)64 * 512;
        for (size_t i = vt; i < (size_t)128 * 256; i += VNT) {
            const int n4 = (int)(i & 255) * 4, gc0 = (int)(i >> 8) * 4, g = gc0 >> 7;
            const float* pw = pool_w + (size_t)gc0 * 128; const float* sc = pool_scale + g * 128; const float* wo = w_out + (size_t)(512 + g * 128) * D + n4;
            f32x4 s0 = (f32x4){0.f, 0.f, 0.f, 0.f}, s1 = s0, s2 = s0, s3 = s0;
#pragma unroll 16
            for (int d = 0; d < 128; ++d) {
                const f32x4 wv = *(const f32x4*)(wo + (size_t)d * D) * sc[d];
                s0 += wv * pw[d]; s1 += wv * pw[128 + d]; s2 += wv * pw[256 + d]; s3 += wv * pw[384 + d];
            }
#pragma unroll
            for (int e = 0; e < 4; ++e) {
                v2u w; w.x = cvt_pk_bf16(s0[e], s1[e]); w.y = cvt_pk_bf16(s2[e], s3[e]);
                *(v2u*)(WMIX + (size_t)(n4 + e) * D + 512 + gc0) = w;
            }
        }
    }
    xcd_barrier(xbar);

    {
        KArgs k = kargs();
        float* out = k->out; const float* x_p = KIN(0); const float* x_s = KIN(1); bf16* AMIX = WSP(bf16, WS_AMIX); bf16* WMIX = WSP(bf16, WS_WMIX); bf16* XMIDB = WSP(bf16, WS_XMIDB); float* SS = WSP(float, WS_SS);
        pg8::Gemm g{AMIX, WMIX, MP, D, D, D}; pg8::StaticOrder S; S.init(MP, D, G, bx);
        EpiOut Ep{x_p, x_s, out, XMIDB, SS, WSP(bf16, WS_XN), WSP(float, WS_RINV), KIN(6)};
        pg8::gemm_phase<EpiOut, pg8::StaticOrder, true, true, 0>(lds, g, S, Ep);
    }
    xcd_barrier(xbar);

    {
        KArgs k = kargs();
        bf16* XMIDB = WSP(bf16, WS_XMIDB); bf16* WUP = WSP(bf16, WS_WUP); float* SS = WSP(float, WS_SS); float* HALO = WSP(float, WS_HALO); unsigned* CTR = WSP(unsigned, WS_CTR);
        pg8::Gemm g{XMIDB - 2 * D, WUP, 512, FF2, D, D}; DepOrder S; S.init(512, FF2, G, bx); S.wait_ctr = CTR; S.wait_need = 0; S.wait_pm = -2; S.done_ctr = CTR; S.done_pm = -1; S.done_rel = false;
        EpiHalo Ep{SS, HALO};
        pg8::gemm_phase<EpiHalo, DepOrder, true, true, 1>(lds, g, S, Ep);
    }
    {
        KArgs k = kargs();
        float* out = k->out; const float* x_p = KIN(0); const float* x_s = KIN(1); bf16* AMIX = WSP(bf16, WS_AMIX); bf16* WMIX = WSP(bf16, WS_WMIX); bf16* XMIDB = WSP(bf16, WS_XMIDB); float* SS = WSP(float, WS_SS); unsigned* CTR = WSP(unsigned, WS_CTR);
        pg8::Gemm g{AMIX, WMIX, 256, D, D, D}; DepOrder S; S.init(256, D, G, (bx + G - 44) % G, 64); S.wait_ctr = CTR; S.wait_need = 0; S.wait_pm = -2; S.done_ctr = CTR + 64; S.done_pm = -1;
        EpiOut Ep{x_p, x_s, out, XMIDB, SS, nullptr, nullptr, nullptr};
        pg8::gemm_phase<EpiOut, DepOrder, true, true, 0>(lds, g, S, Ep);
    }
    {
        KArgs k = kargs();
        float* out = k->out; const float* conv_w = KIN(22); const float* conv_b = KIN(23); const float* st_conv = KIN(5); unsigned* CTR = WSP(unsigned, WS_CTR);
        bf16* XMIDB = WSP(bf16, WS_XMIDB); bf16* WUP = WSP(bf16, WS_WUP); float* SS = WSP(float, WS_SS); float* HALO = WSP(float, WS_HALO); bf16* ACT = WSP(bf16, WS_ACT);
        pg8::Gemm g{XMIDB, WUP, MPAD, FF2, D, D}; DepOrder S; S.init(MPAD, FF2, G, (bx + 150) % G);
        S.wait_ctr = CTR + 64; S.wait_need = 4; S.wait_pm = 64; S.done_ctr = CTR + 128; S.done_pm = 64; S.rot = 2;
        EpiUp Ep{ACT, SS, HALO, conv_w, conv_b, st_conv, out + O_PCONV, out + O_SCONV, CTR, 44u, 0};
        pg8::gemm_phase<EpiUp, DepOrder, true, true, 0>(lds, g, S, Ep);
    }
    if (bx >= 60 && bx < 92) {
        KArgs k = kargs();
        float* out = k->out; const bf16* ACT = WSP(bf16, WS_ACT); const bf16* WDN = WSP(bf16, WS_WDN); unsigned* CTR = WSP(unsigned, WS_CTR);
        if (tid < 64) { unsigned sp = 0;
            while ((unsigned)__builtin_amdgcn_readfirstlane(__hip_atomic_load(CTR + 128, __ATOMIC_RELAXED, __HIP_MEMORY_SCOPE_AGENT)) < 22u) { __builtin_amdgcn_s_sleep(8); if (++sp > (1u << 20)) break; }
            __builtin_amdgcn_fence(__ATOMIC_ACQUIRE, "agent"); asm volatile("s_waitcnt vmcnt(0)" ::: "memory"); }
        __syncthreads();
        const int r16 = lane & 15, q4 = lane >> 4, cb0 = (bx - 60) * 2;
        f32x4 pa[2][8];
#pragma unroll
        for (int j = 0; j < 2; ++j)
#pragma unroll
            for (int rbk = 0; rbk < 8; ++rbk) pa[j][rbk] = (f32x4){0.f, 0.f, 0.f, 0.f};
        const bf16* wp = WDN + ((size_t)(16 * cb0 + r16) * FF + 352 * wave + 8 * q4);
        const bf16* ap = ACT + ((size_t)(MP + r16) * FF + 352 * wave + 8 * q4);
#pragma unroll
        for (int ks = 0; ks < 11; ++ks) {
            const bf16x8 wf0 = *(const bf16x8*)(wp + 32 * ks), wf1 = *(const bf16x8*)(wp + (size_t)16 * FF + 32 * ks);
#pragma unroll
            for (int rbk = 0; rbk < 8; ++rbk) { const bf16x8 af = *(const bf16x8*)(ap + (size_t)rbk * 16 * FF + 32 * ks);
                pa[0][rbk] = __builtin_amdgcn_mfma_f32_16x16x32_bf16(wf0, af, pa[0][rbk], 0, 0, 0); pa[1][rbk] = __builtin_amdgcn_mfma_f32_16x16x32_bf16(wf1, af, pa[1][rbk], 0, 0, 0); }
            asm volatile("" ::: "memory");
        }
        LAS f32x4* red = (LAS f32x4*)lds;
#pragma unroll
        for (int j = 0; j < 2; ++j)
#pragma unroll
            for (int rbk = 0; rbk < 8; ++rbk) red[(wave * 16 + j * 8 + rbk) * 64 + lane] = pa[j][rbk];
        __syncthreads();
#pragma unroll
        for (int t = 0; t < 2; ++t) {
            const int b = 2 * wave + t, j = b >> 3, rbk = b & 7;
            f32x4 sm = (f32x4){0.f, 0.f, 0.f, 0.f};
#pragma unroll
            for (int w2 = 0; w2 < 8; ++w2) sm += red[(w2 * 16 + b) * 64 + lane];
            float* p = out + (size_t)(MP + 16 * rbk + r16) * D + 16 * (cb0 + j) + 4 * q4;
            *(f32x4*)p = *(const f32x4*)p + sm;
        }
        __syncthreads();
    }
    xcd_barrier(xbar);

    {
        KArgs k = kargs();
        float* out = k->out; const float* g_fin = KIN(25);
        for (int m = MP + gw; m < MTOT; m += NGW) {
            f32x4* xr4 = (f32x4*)(out + (size_t)m * D) + lane;
            f32x4 v[4]; float sq = 0.f;
#pragma unroll
            for (int j = 0; j < 4; ++j) { v[j] = xr4[64 * j]; sq += (v[j][0] * v[j][0] + v[j][1] * v[j][1]) + (v[j][2] * v[j][2] + v[j][3] * v[j][3]); }
            const float rstd = rsqrtf(wave_sum(sq) * (1.0f / D) + EPS);
#pragma unroll
            for (int j = 0; j < 4; ++j) { const f32x4 gq = ((const f32x4*)g_fin)[lane + 64 * j]; xr4[64 * j] = v[j] * rstd * gq; }
        }
    }
    {
        KArgs k = kargs();
        float* out = k->out; bf16* ACT = WSP(bf16, WS_ACT); bf16* WDN = WSP(bf16, WS_WDN);
        pg8::Gemm g{ACT, WDN, MP, D, FF, FF}; pg8::StaticOrder S; S.init(MP, D, G, bx);
        EpiDownNorm Ep{WSP(bf16, WS_XMIDB), KIN(25), out, WSP(float, WS_XSLOT), WSP(unsigned, WS_CNT)};
        pg8::gemm_phase<EpiDownNorm, pg8::StaticOrder, true, true, 0, true>(lds, g, S, Ep);
    }
}

extern "C" void kernel_launch(void* const* d_in, const int* in_sizes, int n_in, void* d_out, int out_size, void* d_ws, size_t ws_size, hipStream_t stream) {
    static int grid = 0;
    if (grid == 0) {
        int dev = 0, cus = 0, per_cu = 0;
        (void)hipGetDevice(&dev);
        (void)hipDeviceGetAttribute(&cus, hipDeviceAttributeMultiprocessorCount, dev);
        if (hipFuncSetAttribute((const void*)fwd_kernel, hipFuncAttributeMaxDynamicSharedMemorySize, LDS_BYTES) != hipSuccess) { fprintf(stderr, "hipFuncSetAttribute failed\n"); }
        if (hipOccupancyMaxActiveBlocksPerMultiprocessor(&per_cu, (const void*)fwd_kernel, 512, LDS_BYTES) != hipSuccess || per_cu < 1) { fprintf(stderr, "occupancy query: %d\n", per_cu); per_cu = 1; }
        (void)hipGetLastError();
        grid = cus * per_cu;
        if (ws_size < WS_END) fprintf(stderr, "workspace too small: %zu < %zu\n", ws_size, (size_t)WS_END);
    }
    if (hipMemsetAsync((char*)d_ws + WS_BAR, 0, 49152, stream) != hipSuccess) fprintf(stderr, "memset of barrier words failed\n");
    Args a{};
    for (int i = 0; i < 26; ++i) a.in[i] = (const float*)d_in[i];
    a.out = (float*)d_out; a.ws = (unsigned char*)d_ws;
    void* args[] = {&a};
    hipError_t e = hipLaunchCooperativeKernel((const void*)fwd_kernel, dim3(grid), dim3(512), args, LDS_BYTES, stream);
    if (e != hipSuccess) fprintf(stderr, "cooperative launch failed: %s (grid %d)\n", hipGetErrorString(e), grid);
}
```

```cpp
#include <hip/hip_runtime.h>
#include <hip/hip_cooperative_groups.h>
#include <cstdio>
#include <cstdint>
namespace cg = cooperative_groups;

constexpr int D = 1024, NB = 8, L = 2048, MP = NB * L  , NS = 128, MTOT = MP + NS  , MPAD = 16640  ;
constexpr int DS5 = 512, NG = 32, NH = 16, NP = 64, DPOOL = 512, FF = 2816, FF2 = 5632;
constexpr int TCH = 16, NCH = L / TCH  , NROW = NB * NCH  ;
constexpr float EPS = 1e-6f;

constexpr size_t O_Y = 0, O_YS = 16777216, O_PRE = 16908288, O_PIM = 16924672, O_PPOOL = 16941056, O_PCONV = 17002496,
                 O_SRE = 17092608, O_SIM = 17354752, O_SPOOL = 17616896, O_SCONV = 18599936;

constexpr size_t MiB = 1u << 20;
constexpr size_t WS_WIN = 0, WS_WGLU = 2 * MiB, WS_WMIX = 2 * MiB + MiB / 2, WS_WUP = 4 * MiB + MiB / 2, WS_WDN = 15 * MiB + MiB / 2;
constexpr size_t WS_KTAB = 21 * MiB, WS_W2 = 21 * MiB + MiB / 4, WS_W3 = 23 * MiB + MiB / 4, WS_ABAR = 25 * MiB + MiB / 4, WS_AT = WS_ABAR + 16384, WS_BBAR = WS_ABAR + 32768;
constexpr size_t WS_CTR = 26 * MiB + 160 * 1024;
constexpr size_t WS_CNT = 26 * MiB + 144 * 1024;
constexpr size_t WS_RINV = 224 * MiB + MiB / 2 + MiB / 4;
constexpr size_t WS_XSLOT = 224 * MiB + MiB / 2;
constexpr size_t WS_BAR = 26 * MiB + 128 * 1024;
constexpr size_t WS_SS = 26 * MiB, WS_USAMP = 26 * MiB + MiB / 4, WS_APW = 26 * MiB + MiB / 2;
constexpr size_t WS_XN = 27 * MiB, WS_UPERM = WS_XN + (size_t)MPAD * D * 2, WS_V = WS_UPERM + 16 * MiB, WS_E = WS_V + (size_t)MPAD * 512 * 4,
                 WS_HIN = WS_E + 16 * MiB, WS_YG = WS_HIN + 8 * MiB, WS_AMIX = WS_YG + (size_t)MPAD * 512 * 2, WS_XMIDB = WS_AMIX + (size_t)MPAD * D * 2,
                 WS_HALO = WS_XMIDB + (size_t)MPAD * D * 2, WS_END = WS_HALO + (size_t)512 * FF2 * 4;
constexpr size_t WS_ACT = WS_XN;
static_assert(WS_END <= 256 * MiB, "ws map");
static_assert(WS_ACT + (size_t)MPAD * FF * 2 <= WS_YG, "ACT overlay must stay below live buffers");

constexpr int LDS_BYTES = 147456;

#define LAS __attribute__((address_space(3)))
typedef unsigned short bf16;
typedef unsigned v4u __attribute__((ext_vector_type(4)));
typedef unsigned v2u __attribute__((ext_vector_type(2)));
typedef float f32x4 __attribute__((ext_vector_type(4)));
typedef float f32x2 __attribute__((ext_vector_type(2)));
typedef short bf16x8 __attribute__((ext_vector_type(8)));
#define LDS_WAIT() asm volatile("s_waitcnt lgkmcnt(0)" ::: "memory")

__device__ __forceinline__ unsigned cvt_pk_bf16(float lo, float hi) { unsigned r; asm volatile("v_cvt_pk_bf16_f32 %0, %1, %2" : "=v"(r) : "v"(lo), "v"(hi)); return r; }
__device__ __forceinline__ float bf2f(unsigned b) { return __uint_as_float(b << 16); }
__device__ __forceinline__ float gelu_exact(float v) { return 0.5f * v * (1.0f + erff(v * 0.70710678118654752f)); }
__device__ __forceinline__ f32x2 gelu_pk(f32x2 v) {
    const f32x2 av = __builtin_elementwise_abs(v), d = av * 0.2316418882f + 1.0f;
    f32x2 t; t.x = __builtin_amdgcn_rcpf(d.x); t.y = __builtin_amdgcn_rcpf(d.y);
    f32x2 q = t * 0.5307027145f + (-0.7265760135f); q = q * t + 0.7107068705f; q = q * t + (-0.142248368f); q = q * t + 0.127414796f; q = q * t;
    const f32x2 s = (v * v) * (-0.72134752044f);
    f32x2 e; e.x = __builtin_amdgcn_exp2f(s.x); e.y = __builtin_amdgcn_exp2f(s.y);
    const f32x2 m = v * (q * e), r = v - m;
    f32x2 o; o.x = v.x < 0.f ? m.x : r.x; o.y = v.y < 0.f ? m.y : r.y; return o;
}
__device__ __forceinline__ f32x4 gelu4(f32x4 v) { f32x2 a = gelu_pk((f32x2){v[0], v[1]}), b = gelu_pk((f32x2){v[2], v[3]}); return (f32x4){a.x, a.y, b.x, b.y}; }
__device__ __forceinline__ float sigmoidf_(float x) { return __builtin_amdgcn_rcpf(1.0f + __expf(-x)); }
__device__ __forceinline__ float wave_sum(float v) {
#pragma unroll
    for (int o = 1; o < 64; o <<= 1) v += __shfl_xor(v, o);
    return v;
}

namespace pg8 {
#define PG8_LAS __attribute__((address_space(3)))
typedef unsigned short bf16_t;
constexpr int BM = 256, BK = 64, HALF = 128, HTB = HALF * BK * 2, STAGE_BYTES = 8 * HTB, NXCD = 8, WGM = 8;
__host__ __device__ __forceinline__ int lds_byte(int r, int c) { const int st = (r >> 4) * 2 + (c >> 5), rr = r & 15, cc = c & 31, ob = rr * 64 + cc * 2; return st * 1024 + (ob ^ (((ob >> 9) & 1) << 5)); }
__host__ __device__ __forceinline__ void stage_rc(int b, int& R, int& C) { const int st = b / 1024, sb = b % 1024, swz = sb ^ (((sb >> 9) & 1) << 5); R = (st >> 1) * 16 + swz / 64; C = (st & 1) * 32 + (swz % 64) / 2; }
__host__ __device__ __forceinline__ int perm32(int rho) { const int n = rho >> 4, i = rho & 15; return 8 * (i >> 2) + 4 * n + (i & 3); }
struct Unit { int pm, pn; };
struct Gemm { const bf16_t* A; const bf16_t* Bt; int M, N, K, ld; };
struct StaticOrder {
    int nM, nN, nwg, G, c, pm_off, lim, L_off;
    __host__ __device__ void init(int M, int N, int G_, int c_, int pm_off_ = 0) { nM = M / BM; nN = N / BM; nwg = nM * nN; G = G_; c = c_; pm_off = pm_off_; lim = nwg; L_off = 0; }
    __host__ __device__ __forceinline__ bool next(int i, Unit& u) const { return from_L(L_off + i * G + c, u); }
    __host__ __device__ __forceinline__ bool from_L(int Lq, Unit& u) const {
        if (Lq >= lim) return false;
        int wgid = Lq; { const int q = nwg / NXCD, r = nwg % NXCD, xcd = wgid % NXCD, off = wgid / NXCD; wgid = (xcd < r ? xcd * (q + 1) : r * (q + 1) + (xcd - r) * q) + off; }
        const int nig = WGM * nN, gid = wgid / nig, fm = gid * WGM, gsz = (nM - fm) < WGM ? (nM - fm) : WGM;
        u.pm = pm_off + fm + ((wgid % nig) % gsz); u.pn = (wgid % nig) / gsz; return true;
    }
    __device__ __forceinline__ void a_ready(const Unit&) const {}
    __device__ __forceinline__ void done(const Unit&) const {}
};
template <class Epi, class Sched, bool ALIGN_EPI = false, bool SP2 = false, int AMODE = 0, bool AFTER_DRAIN = false>
__device__ __forceinline__ void gemm_phase(PG8_LAS unsigned char* lds, const Gemm g, const Sched& S, const Epi& E) {
    int tid_ = threadIdx.x; asm volatile("" : "+v"(tid_));
    const int tid = tid_, wid = __builtin_amdgcn_readfirstlane(tid >> 6), lane = tid & 63, wr = wid >> 2, wc = wid & 3, fr = lane & 15, fq = lane >> 4;
    const int K = g.K, nt = K / BK;
    unsigned voffA[2], voffB[2];
#pragma unroll
    for (int i = 0; i < 2; ++i) { int R, C; stage_rc(tid * 16 + i * 8192, R, C); const int Rb = Epi::PERM ? ((R & ~31) + perm32(R & 31)) : R;
        const int Ra = (AMODE == 1) ? (32 * R - 31 * (R & 1)) : R;
        voffA[i] = (unsigned)(Ra * g.ld + C) * 2u; voffB[i] = (unsigned)(Rb * g.ld + C) * 2u; }
    const size_t kstep = (size_t)(BK * 2);
    const size_t hstepB = (size_t)HALF * g.ld * 2, tstepB = 2 * hstepB;
    const size_t hstepA = (AMODE == 1) ? hstepB * 32 : hstepB, tstepA = 2 * hstepA;
    const unsigned ldsw = (unsigned)wid * 1024u;
    const int aoff = lds_byte(wr * 64 + fr, fq * 8), boff = lds_byte(wc * 32 + fr, fq * 8);
#define PG8_SA(b, h) (((b) * 2 + (h)) * HTB)
#define PG8_SB(b, h) ((4 + (b) * 2 + (h)) * HTB)
#define PG8_STAGE(bufoff, gbase, voff) do { _Pragma("unroll") for (int _i = 0; _i < 2; ++_i) \
        __builtin_amdgcn_global_load_lds((const unsigned*)((const char*)(gbase) + (voff)[_i]), (PG8_LAS unsigned*)(lds + (bufoff) + ldsw + _i * 8192), 16, 0, 0); } while (0)
#define PG8_LDA(dst, b, h) do { _Pragma("unroll") for (int m = 0; m < 4; ++m) _Pragma("unroll") for (int k = 0; k < 2; ++k) dst[m][k] = *(const PG8_LAS bf16x8*)(lds + PG8_SA(b, h) + aoff + m * 2048 + k * 1024); } while (0)
#define PG8_LDB(dst, b, h) do { _Pragma("unroll") for (int n = 0; n < 2; ++n) _Pragma("unroll") for (int k = 0; k < 2; ++k) dst[n][k] = *(const PG8_LAS bf16x8*)(lds + PG8_SB(b, h) + boff + n * 2048 + k * 1024); } while (0)
#define PG8_MMA(ai, bj, At, Bt) do { __builtin_amdgcn_s_setprio(1); _Pragma("unroll") for (int m = 0; m < 4; ++m) _Pragma("unroll") for (int n = 0; n < 2; ++n) _Pragma("unroll") for (int k = 0; k < 2; ++k) \
        acc[ai][bj][m][n] = __builtin_amdgcn_mfma_f32_16x16x32_bf16(Bt[n][k], At[m][k], acc[ai][bj][m][n], 0, 0, 0); __builtin_amdgcn_s_setprio(0); } while (0)
#define PG8_WAIT_V(n) asm volatile("s_waitcnt vmcnt(" #n ")" ::: "memory")
#define PG8_WAIT_L(n) asm volatile("s_waitcnt lgkmcnt(" #n ")" ::: "memory")
#define PG8_BAR __builtin_amdgcn_s_barrier()
#define PG8_SCHED __builtin_amdgcn_sched_barrier(0)
    Unit cur, nxt; int ui = 0;
    if (!S.next(0, cur)) return;
    f32x4 acc[2][2][4][2];
#pragma unroll
    for (int a = 0; a < 2; ++a)
#pragma unroll
        for (int b = 0; b < 2; ++b)
#pragma unroll
            for (int m = 0; m < 4; ++m)
#pragma unroll
                for (int n = 0; n < 2; ++n) acc[a][b][m][n] = (f32x4){0.f, 0.f, 0.f, 0.f};
    bf16x8 At[4][2], B0[2][2], B1[2][2];
    const char* cA = (const char*)g.A + (size_t)cur.pm * tstepA; const char* cB = (const char*)g.Bt + (size_t)cur.pn * tstepB;
    S.a_ready(cur);
    if constexpr (SP2) {
        PG8_STAGE(PG8_SB(0, 0), cB, voffB); PG8_STAGE(PG8_SB(0, 1), cB + hstepB, voffB); PG8_STAGE(PG8_SA(0, 0), cA, voffA); PG8_STAGE(PG8_SA(0, 1), cA + hstepA, voffA);
        if (wr == 1) PG8_BAR;
        PG8_WAIT_V(2); PG8_BAR;
        PG8_STAGE(PG8_SB(1, 0), cB + kstep, voffB); PG8_STAGE(PG8_SA(1, 0), cA + kstep, voffA); PG8_STAGE(PG8_SB(1, 1), cB + hstepB + kstep, voffB);
        PG8_WAIT_V(6); PG8_BAR;
    } else {
        PG8_STAGE(PG8_SB(0, 0), cB, voffB); PG8_STAGE(PG8_SA(0, 0), cA, voffA); PG8_STAGE(PG8_SB(0, 1), cB + hstepB, voffB); PG8_STAGE(PG8_SA(0, 1), cA + hstepA, voffA);
        if (wr == 1) PG8_BAR;
        PG8_WAIT_V(4); PG8_BAR;
        PG8_STAGE(PG8_SB(1, 0), cB + kstep, voffB); PG8_STAGE(PG8_SA(1, 0), cA + kstep, voffA); PG8_STAGE(PG8_SB(1, 1), cB + hstepB + kstep, voffB);
        PG8_WAIT_V(6); PG8_BAR;
    }
    for (;;) {
        const bool has_next = S.next(ui + 1, nxt);
        const char* nA = has_next ? (const char*)g.A + (size_t)nxt.pm * tstepA : cA; const char* nB = has_next ? (const char*)g.Bt + (size_t)nxt.pn * tstepB : cB;
        for (int t = 0; t < nt; t += 2) {
            const bool last = (t == nt - 2);
            const char* a1 = cA + (size_t)(t + 1) * kstep;
            const char* a2 = last ? nA : cA + (size_t)(t + 2) * kstep; const char* b2 = last ? nB : cB + (size_t)(t + 2) * kstep;
            const char* a3 = a2 + kstep; const char* b3 = b2 + kstep;
            if (last && has_next) S.a_ready(nxt);
            if constexpr (SP2) {
            PG8_LDB(B0, 0, 0); PG8_LDB(B1, 0, 1); PG8_SCHED; PG8_LDA(At, 0, 0); PG8_STAGE(PG8_SA(1, 1), a1 + hstepA, voffA);
            PG8_WAIT_V(8); PG8_WAIT_L(0); PG8_BAR; PG8_MMA(0, 0, At, B0); PG8_MMA(0, 1, At, B1); PG8_BAR; PG8_SCHED;
            PG8_LDA(At, 0, 1); PG8_STAGE(PG8_SB(0, 0), b2, voffB); PG8_STAGE(PG8_SB(0, 1), b2 + hstepB, voffB); PG8_STAGE(PG8_SA(0, 0), a2, voffA);
            PG8_WAIT_V(8); PG8_WAIT_L(0); PG8_BAR; PG8_MMA(1, 0, At, B0); PG8_MMA(1, 1, At, B1); PG8_BAR; PG8_SCHED;
            PG8_LDB(B0, 1, 0); PG8_LDB(B1, 1, 1); PG8_SCHED; PG8_LDA(At, 1, 0); PG8_STAGE(PG8_SA(0, 1), a2 + hstepA, voffA);
            PG8_WAIT_V(8); PG8_WAIT_L(0); PG8_BAR; PG8_MMA(0, 0, At, B0); PG8_MMA(0, 1, At, B1); PG8_BAR; PG8_SCHED;
            PG8_LDA(At, 1, 1); PG8_STAGE(PG8_SB(1, 0), b3, voffB); PG8_STAGE(PG8_SB(1, 1), b3 + hstepB, voffB); PG8_STAGE(PG8_SA(1, 0), a3, voffA);
            PG8_WAIT_V(8); PG8_WAIT_L(0); PG8_BAR; PG8_MMA(1, 0, At, B0); PG8_MMA(1, 1, At, B1); PG8_BAR; PG8_SCHED;
            } else {
            PG8_LDB(B0, 0, 0); PG8_SCHED; PG8_LDA(At, 0, 0); PG8_STAGE(PG8_SA(1, 1), a1 + hstepA, voffA);
            PG8_WAIT_L(8); PG8_BAR; PG8_WAIT_L(0); PG8_MMA(0, 0, At, B0); PG8_BAR; PG8_SCHED;
            PG8_LDB(B1, 0, 1); PG8_STAGE(PG8_SB(0, 0), b2, voffB);
            PG8_BAR; PG8_WAIT_L(0); PG8_MMA(0, 1, At, B1); PG8_BAR;
            PG8_LDA(At, 0, 1); PG8_STAGE(PG8_SA(0, 0), a2, voffA);
            PG8_BAR; PG8_WAIT_L(0); PG8_MMA(1, 0, At, B0); PG8_BAR; PG8_SCHED;
            PG8_STAGE(PG8_SB(0, 1), b2 + hstepB, voffB);
            PG8_WAIT_V(6); PG8_BAR; PG8_MMA(1, 1, At, B1); PG8_BAR;
            PG8_LDB(B0, 1, 0); PG8_SCHED; PG8_LDA(At, 1, 0); PG8_STAGE(PG8_SA(0, 1), a2 + hstepA, voffA);
            PG8_WAIT_L(8); PG8_BAR; PG8_WAIT_L(0); PG8_MMA(0, 0, At, B0); PG8_BAR; PG8_SCHED;
            PG8_LDB(B1, 1, 1); PG8_STAGE(PG8_SB(1, 0), b3, voffB);
            PG8_BAR; PG8_WAIT_L(0); PG8_MMA(0, 1, At, B1); PG8_BAR;
            PG8_LDA(At, 1, 1); PG8_STAGE(PG8_SA(1, 0), a3, voffA);
            PG8_BAR; PG8_WAIT_L(0); PG8_MMA(1, 0, At, B0); PG8_BAR; PG8_SCHED;
            PG8_STAGE(PG8_SB(1, 1), b3 + hstepB, voffB);
            PG8_WAIT_V(6); PG8_BAR; PG8_MMA(1, 1, At, B1); PG8_BAR;
            }
        }
        if constexpr (ALIGN_EPI) { if (wr == 0) PG8_BAR; }
        if constexpr (!AFTER_DRAIN) { E(acc, cur, wr, wc, fr, fq); S.done(cur); }
        if (!has_next) break;
#pragma unroll
        for (int a = 0; a < 2; ++a)
#pragma unroll
            for (int b = 0; b < 2; ++b)
#pragma unroll
                for (int m = 0; m < 4; ++m)
#pragma unroll
                    for (int n = 0; n < 2; ++n) acc[a][b][m][n] = (f32x4){0.f, 0.f, 0.f, 0.f};
        cur = nxt; cA = nA; cB = nB; ++ui;
        if constexpr (ALIGN_EPI) { if (wr == 1) PG8_BAR; }
    }
    PG8_WAIT_V(0);
    if constexpr (!ALIGN_EPI) { if (wr == 0) PG8_BAR; }
    PG8_BAR;
    if constexpr (AFTER_DRAIN) { E.fused(acc, cur, wr, wc, fr, fq, lds, wid, lane); }
#undef PG8_SA
#undef PG8_SB
#undef PG8_STAGE
#undef PG8_LDA
#undef PG8_LDB
#undef PG8_MMA
#undef PG8_WAIT_V
#undef PG8_WAIT_L
#undef PG8_BAR
#undef PG8_SCHED
}
}
using pg8::Unit;

struct EpiProj {
    static constexpr bool PERM = true;
    bf16* UPERM; float* USAMP; float* V;
    __device__ __forceinline__ void operator()(const f32x4 (&acc)[2][2][4][2], const Unit& u, int wr, int wc, int fr, int fq) const {
#pragma unroll
        for (int ai = 0; ai < 2; ++ai)
#pragma unroll
            for (int m = 0; m < 4; ++m) {
                const int row = u.pm * 256 + ai * 128 + wr * 64 + m * 16 + fr;
#pragma unroll
                for (int bj = 0; bj < 2; ++bj) {
                    const int col0 = u.pn * 256 + bj * 128 + wc * 32 + fq * 8;
                    const f32x4 v0 = acc[ai][bj][m][0], v1 = acc[ai][bj][m][1];
                    if (u.pn < 2) {
                        if (u.pm < 64) {
                            const int g = col0 >> 4, h0 = col0 & 15, nb = row >> 11, tl = row & 2047, c = tl >> 4, j = tl & 15;
                            v4u w; w.x = cvt_pk_bf16(v0[0], v0[1]); w.y = cvt_pk_bf16(v0[2], v0[3]); w.z = cvt_pk_bf16(v1[0], v1[1]); w.w = cvt_pk_bf16(v1[2], v1[3]);
                            *(v4u*)(UPERM + ((size_t)(g * NROW + nb * NCH + c) * 256 + j * 16 + h0)) = w;
                        } else {
                            const int ns = row - MP;
                            if (ns < NS) { *(f32x4*)(USAMP + (size_t)ns * 512 + col0) = v0; *(f32x4*)(USAMP + (size_t)ns * 512 + col0 + 4) = v1; }
                        }
                    } else {
                        float* p = V + (size_t)row * 512 + (col0 - 512);
                        *(f32x4*)p = v0; *(f32x4*)(p + 4) = v1;
                    }
                }
            }
    }
};
struct EpiGlu {
    static constexpr bool PERM = true;
    const bf16* YG; bf16* AMIX;
    __device__ __forceinline__ void operator()(const f32x4 (&acc)[2][2][4][2], const Unit& u, int wr, int wc, int fr, int fq) const {
#pragma unroll
        for (int ai = 0; ai < 2; ++ai)
#pragma unroll
            for (int m = 0; m < 4; ++m) {
                const int row = u.pm * 256 + ai * 128 + wr * 64 + m * 16 + fr;
#pragma unroll
                for (int bj = 0; bj < 2; ++bj) {
                    const int col0 = u.pn * 256 + bj * 128 + wc * 32 + fq * 8;
                    const f32x4 v0 = acc[ai][bj][m][0], v1 = acc[ai][bj][m][1];
                    const v4u y = *(const v4u*)(YG + (size_t)row * 512 + col0);
                    float o[8];
                    o[0] = bf2f(y.x & 0xffffu) * sigmoidf_(v0[0]); o[1] = bf2f(y.x >> 16) * sigmoidf_(v0[1]);
                    o[2] = bf2f(y.y & 0xffffu) * sigmoidf_(v0[2]); o[3] = bf2f(y.y >> 16) * sigmoidf_(v0[3]);
                    o[4] = bf2f(y.z & 0xffffu) * sigmoidf_(v1[0]); o[5] = bf2f(y.z >> 16) * sigmoidf_(v1[1]);
                    o[6] = bf2f(y.w & 0xffffu) * sigmoidf_(v1[2]); o[7] = bf2f(y.w >> 16) * sigmoidf_(v1[3]);
                    v4u w; w.x = cvt_pk_bf16(o[0], o[1]); w.y = cvt_pk_bf16(o[2], o[3]); w.z = cvt_pk_bf16(o[4], o[5]); w.w = cvt_pk_bf16(o[6], o[7]);
                    *(v4u*)(AMIX + (size_t)row * D + col0) = w;
                }
                if (m == 3) asm volatile("" ::: "memory");
            }
    }
};
struct EpiOut {
    static constexpr bool PERM = true;
    const float* xp; const float* xs; float* out; bf16* XMIDB; float* SS; const bf16* XN; const float* RINV; const float* gmix;
    __device__ __forceinline__ void operator()(const f32x4 (&acc)[2][2][4][2], const Unit& u, int wr, int wc, int fr, int fq) const {
        const bool recon = (XN != nullptr) && (u.pm < 64);
        f32x4 gi[2][2];
        if (recon) {
#pragma unroll
            for (int bj = 0; bj < 2; ++bj) { const int col0 = u.pn * 256 + bj * 128 + wc * 32 + fq * 8;
#pragma unroll
                for (int n = 0; n < 2; ++n) { const f32x4 gq = *(const f32x4*)(gmix + col0 + 4 * n);
                    gi[bj][n] = (f32x4){__builtin_amdgcn_rcpf(gq[0]), __builtin_amdgcn_rcpf(gq[1]), __builtin_amdgcn_rcpf(gq[2]), __builtin_amdgcn_rcpf(gq[3])}; } }
        }
#pragma unroll
        for (int ai = 0; ai < 2; ++ai)
#pragma unroll
            for (int m = 0; m < 4; ++m) {
                const int row = u.pm * 256 + ai * 128 + wr * 64 + m * 16 + fr;
                const bool valid = row < MTOT;
                const float* xr = row < MP ? xp + (size_t)row * D : xs + (size_t)(valid ? row - MP : 0) * D;
                const float ri = recon ? RINV[row] : 0.f;
                float ss = 0.f;
#pragma unroll
                for (int bj = 0; bj < 2; ++bj) {
                    const int col0 = u.pn * 256 + bj * 128 + wc * 32 + fq * 8;
                    f32x4 x0 = (f32x4){0.f, 0.f, 0.f, 0.f}, x1 = x0;
                    if (recon) {
                        const v4u xb = *(const v4u*)(XN + (size_t)row * D + col0);
                        x0 = (f32x4){bf2f(xb.x & 0xffffu), bf2f(xb.x >> 16), bf2f(xb.y & 0xffffu), bf2f(xb.y >> 16)} * gi[bj][0] * ri;
                        x1 = (f32x4){bf2f(xb.z & 0xffffu), bf2f(xb.z >> 16), bf2f(xb.w & 0xffffu), bf2f(xb.w >> 16)} * gi[bj][1] * ri;
                    } else if (valid) { x0 = *(const f32x4*)(xr + col0); x1 = *(const f32x4*)(xr + col0 + 4); }
                    const f32x4 v0 = acc[ai][bj][m][0] + x0, v1 = acc[ai][bj][m][1] + x1;
                    ss += (v0[0] * v0[0] + v0[1] * v0[1]) + (v0[2] * v0[2] + v0[3] * v0[3]) + (v1[0] * v1[0] + v1[1] * v1[1]) + (v1[2] * v1[2] + v1[3] * v1[3]);
                    if (valid && row >= MP) { *(f32x4*)(out + (size_t)row * D + col0) = v0; *(f32x4*)(out + (size_t)row * D + col0 + 4) = v1; }
                    v4u w; w.x = cvt_pk_bf16(v0[0], v0[1]); w.y = cvt_pk_bf16(v0[2], v0[3]); w.z = cvt_pk_bf16(v1[0], v1[1]); w.w = cvt_pk_bf16(v1[2], v1[3]);
                    *(v4u*)(XMIDB + (size_t)row * D + col0) = w;
                }
                ss += __shfl_xor(ss, 16); ss += __shfl_xor(ss, 32);
                if (fq == 0) atomicAdd(SS + row, ss);
                if (m & 1) asm volatile("" ::: "memory");
            }
    }
};
struct EpiHalo {
    static constexpr bool PERM = true;
    const float* SS; float* HALO;
    __device__ __forceinline__ void operator()(const f32x4 (&acc)[2][2][4][2], const Unit& u, int wr, int wc, int fr, int fq) const {
#pragma unroll
        for (int ai = 0; ai < 2; ++ai)
#pragma unroll
            for (int m = 0; m < 4; ++m) {
                const int hr = u.pm * 256 + ai * 128 + wr * 64 + m * 16 + fr;
                const int orig = 32 * hr - 31 * (hr & 1) - 2;
                const float rs = orig >= 0 ? rsqrtf(SS[orig] * (1.0f / D) + EPS) : 0.f;
#pragma unroll
                for (int bj = 0; bj < 2; ++bj) {
                    const int col0 = u.pn * 256 + bj * 128 + wc * 32 + fq * 8;
                    float* p = HALO + (size_t)hr * FF2 + col0;
                    const f32x4 h0 = acc[ai][bj][m][0] * rs, h1 = acc[ai][bj][m][1] * rs;
                    asm volatile("global_store_dwordx4 %0, %1, off sc1\n\ts_nop 1" :: "v"(p), "v"(h0) : "memory");
                    asm volatile("global_store_dwordx4 %0, %1, off offset:16 sc1\n\ts_nop 1" :: "v"(p), "v"(h1) : "memory");
                }
            }
    }
};
struct EpiUp {
    static constexpr bool PERM = true;
    bf16* ACT; const float* SS; const float* HALO; const float* convw; const float* convb; const float* state; float* ncp; float* ncs;
    unsigned* halo_ctr; unsigned halo_need; mutable int halo_ok;
    __device__ __forceinline__ void operator()(const f32x4 (&acc)[2][2][4][2], const Unit& u, int wr, int wc, int fr, int fq) const {
        const int lane = threadIdx.x & 63;
        if (!halo_ok) {
            if (threadIdx.x < 64) { unsigned sp = 0;
                while ((unsigned)__builtin_amdgcn_readfirstlane(__hip_atomic_load(halo_ctr, __ATOMIC_RELAXED, __HIP_MEMORY_SCOPE_AGENT)) < halo_need) { __builtin_amdgcn_s_sleep(8); if (++sp > (1u << 20)) break; }
                __builtin_amdgcn_fence(__ATOMIC_ACQUIRE, "agent"); asm volatile("s_waitcnt vmcnt(0)" ::: "memory"); }
            asm volatile("" ::: "memory"); __builtin_amdgcn_s_barrier(); asm volatile("" ::: "memory");
            halo_ok = 1;
        }
        const bool samp = (u.pm == 64);
#pragma unroll
        for (int ai = 0; ai < 2; ++ai) {
            const int rowb = u.pm * 256 + ai * 128 + wr * 64;
            const int blk = 4 * u.pm + 2 * ai + wr;
            float rs[4];
#pragma unroll
            for (int m = 0; m < 4; ++m) rs[m] = rsqrtf(SS[rowb + 16 * m + fr] * (1.0f / D) + EPS);
#pragma unroll
            for (int n = 0; n < 2; ++n) {
                f32x4 cg[4];
#pragma unroll
                for (int bj = 0; bj < 2; ++bj) {
                    const int oc = (bj ? FF : 0) + 128 * u.pn + 32 * wc + 8 * fq + 4 * n;
                    const int cgc = 256 * u.pn + 128 * bj + 32 * wc + 8 * fq + 4 * n;
                    const f32x4 cw0 = *(const f32x4*)(convw + oc), cw1 = *(const f32x4*)(convw + FF2 + oc), cw2 = *(const f32x4*)(convw + 2 * FF2 + oc), cb = *(const f32x4*)(convb + oc);
                    f32x4 v[4];
#pragma unroll
                    for (int m = 0; m < 4; ++m) v[m] = acc[ai][bj][m][n] * rs[m];
                    f32x4 hv = (f32x4){0.f, 0.f, 0.f, 0.f};
                    if (!samp) {
                        if ((blk & 31) != 0 && fr >= 14) hv = *(const f32x4*)(HALO + (size_t)(2 * blk + fr - 14) * FF2 + cgc);
                        if ((u.pm & 7) == 7 && ai == 1 && wr == 1 && fr >= 14) *(f32x4*)(ncp + (size_t)((u.pm >> 3) * 2 + (fr - 14)) * FF2 + oc) = v[3];
                    }
#pragma unroll
                    for (int m = 0; m < 4; ++m) {
                        f32x4 cv;
                        if (!samp) {
                            const f32x4 prev = m ? v[m - 1] : hv;
#pragma unroll
                            for (int e = 0; e < 4; ++e) {
                                const int vi = __float_as_int(v[m][e]), pi = __float_as_int(prev[e]);
                                const int o1 = __builtin_amdgcn_mov_dpp(pi, 0x121, 0xf, 0xf, false);
                                const int o2 = __builtin_amdgcn_mov_dpp(pi, 0x122, 0xf, 0xf, false);
                                const float p1 = __int_as_float(__builtin_amdgcn_update_dpp(o1, vi, 0x111, 0xf, 0xf, false));
                                const float p2 = __int_as_float(__builtin_amdgcn_update_dpp(o2, vi, 0x112, 0xf, 0xf, false));
                                cv[e] = cb[e] + cw0[e] * p2 + cw1[e] * p1 + cw2[e] * v[m][e];
                            }
                        } else {
                            const int ns = rowb + 16 * m + fr - MP;
                            f32x4 s0 = (f32x4){0.f, 0.f, 0.f, 0.f}, s1 = s0;
                            if (ns < NS) {
                                s0 = *(const f32x4*)(state + (size_t)(ns * 2 + 0) * FF2 + oc); s1 = *(const f32x4*)(state + (size_t)(ns * 2 + 1) * FF2 + oc);
                                *(f32x4*)(ncs + (size_t)(ns * 2 + 0) * FF2 + oc) = s1; *(f32x4*)(ncs + (size_t)(ns * 2 + 1) * FF2 + oc) = v[m];
                            }
                            cv = cb + cw0 * s0 + cw1 * s1 + cw2 * v[m];
                        }
                        if (bj == 0) cg[m] = gelu4(cv);
                        else {
                            const f32x4 r = cg[m] * cv;
                            v2u w; w.x = cvt_pk_bf16(r[0], r[1]); w.y = cvt_pk_bf16(r[2], r[3]);
                            *(v2u*)(ACT + (size_t)(rowb + 16 * m + fr) * FF + 128 * u.pn + 32 * wc + 8 * fq + 4 * n) = w;
                        }
                    }
                    asm volatile("" ::: "memory");
                }
            }
        }
    }
};
template <bool ATOMIC> struct EpiDown {
    static constexpr bool PERM = true;
    float* out;
    __device__ __forceinline__ void operator()(const f32x4 (&acc)[2][2][4][2], const Unit& u, int wr, int wc, int fr, int fq) const {
#pragma unroll
        for (int ai = 0; ai < 2; ++ai)
#pragma unroll
            for (int m = 0; m < 4; ++m) {
                const int row = u.pm * 256 + ai * 128 + wr * 64 + m * 16 + fr;
                if (row < MTOT) {
#pragma unroll
                    for (int bj = 0; bj < 2; ++bj) {
                        const int col0 = u.pn * 256 + bj * 128 + wc * 32 + fq * 8;
                        float* p = out + (size_t)row * D + col0;
                        if (ATOMIC) {
#pragma unroll
                            for (int e = 0; e < 4; ++e) { atomicAdd(p + e, acc[ai][bj][m][0][e]); atomicAdd(p + 4 + e, acc[ai][bj][m][1][e]); }
                        } else {
                            const f32x4 x0 = *(const f32x4*)p, x1 = *(const f32x4*)(p + 4);
                            *(f32x4*)p = x0 + acc[ai][bj][m][0]; *(f32x4*)(p + 4) = x1 + acc[ai][bj][m][1];
                        }
                    }
                }
                asm volatile("" ::: "memory");
            }
    }
};


struct EpiDownNorm {
    static constexpr bool PERM = true;
    const bf16* XMIDB; const float* gfin; float* out; float* xslot; unsigned* cnt;
    __device__ __forceinline__ void fused(f32x4 (&acc)[2][2][4][2], const Unit& u, int wr, int wc, int fr, int fq, LAS unsigned char* lds, int wid, int lane) const {
        LAS float* P = (LAS float*)lds;
        LAS float* S = (LAS float*)(lds + 4096);
#pragma unroll
        for (int ai = 0; ai < 2; ++ai)
#pragma unroll
            for (int m = 0; m < 4; ++m) {
                const int r = ai * 128 + wr * 64 + m * 16 + fr; const size_t row = (size_t)u.pm * 256 + r;
                float ss = 0.f;
#pragma unroll
                for (int bj = 0; bj < 2; ++bj) {
                    const int col0 = u.pn * 256 + bj * 128 + wc * 32 + fq * 8;
                    const v4u xb = *(const v4u*)(XMIDB + row * D + col0);
                    f32x4 v0 = acc[ai][bj][m][0], v1 = acc[ai][bj][m][1];
                    v0[0] += bf2f(xb.x & 0xffffu); v0[1] += bf2f(xb.x >> 16); v0[2] += bf2f(xb.y & 0xffffu); v0[3] += bf2f(xb.y >> 16);
                    v1[0] += bf2f(xb.z & 0xffffu); v1[1] += bf2f(xb.z >> 16); v1[2] += bf2f(xb.w & 0xffffu); v1[3] += bf2f(xb.w >> 16);
                    acc[ai][bj][m][0] = v0; acc[ai][bj][m][1] = v1;
                    ss += (v0[0] * v0[0] + v0[1] * v0[1]) + (v0[2] * v0[2] + v0[3] * v0[3]) + (v1[0] * v1[0] + v1[1] * v1[1]) + (v1[2] * v1[2] + v1[3] * v1[3]);
                }
                ss += __shfl_xor(ss, 16); ss += __shfl_xor(ss, 32);
                if (fq == 0) P[r * 4 + wc] = ss;
                if (m == 3) asm volatile("" ::: "memory");
            }
        __syncthreads();
        const int row = wid * 32 + (lane & 31);
        if (lane < 32) {
            const float t = (P[row * 4 + 0] + P[row * 4 + 1]) + (P[row * 4 + 2] + P[row * 4 + 3]);
            __hip_atomic_store(xslot + ((size_t)(u.pm * 256 + row) * 4 + u.pn), t, __ATOMIC_RELAXED, __HIP_MEMORY_SCOPE_AGENT);
        }
        asm volatile("s_waitcnt vmcnt(0)" ::: "memory");
        if (lane == 0) __hip_atomic_fetch_add(cnt + 64 * u.pm, 1u, __ATOMIC_RELAXED, __HIP_MEMORY_SCOPE_AGENT);
        if (wid == 0) {
            unsigned sp = 0;
            while ((unsigned)__builtin_amdgcn_readfirstlane(__hip_atomic_load(cnt + 64 * u.pm, __ATOMIC_RELAXED, __HIP_MEMORY_SCOPE_AGENT)) < 32u) { __builtin_amdgcn_s_sleep(2); if (++sp > (1u << 20)) break; }
            __builtin_amdgcn_fence(__ATOMIC_ACQUIRE, "agent");
        }
        asm volatile("s_waitcnt vmcnt(0) lgkmcnt(0)" ::: "memory");
        __syncthreads();
        if (lane < 32) {
            const float* sl = xslot + (size_t)(u.pm * 256 + row) * 4; float t = 0.f;
#pragma unroll
            for (int q = 0; q < 4; ++q) t += __hip_atomic_load(sl + q, __ATOMIC_RELAXED, __HIP_MEMORY_SCOPE_AGENT);
            S[row] = rsqrtf(t * (1.0f / D) + EPS);
        }
        __syncthreads();
        f32x4 gv[2][2];
#pragma unroll
        for (int bj = 0; bj < 2; ++bj) { const int col0 = u.pn * 256 + bj * 128 + wc * 32 + fq * 8; gv[bj][0] = *(const f32x4*)(gfin + col0); gv[bj][1] = *(const f32x4*)(gfin + col0 + 4); }
#pragma unroll
        for (int ai = 0; ai < 2; ++ai)
#pragma unroll
            for (int m = 0; m < 4; ++m) {
                const int r = ai * 128 + wr * 64 + m * 16 + fr; const size_t row2 = (size_t)u.pm * 256 + r; const float rs = S[r];
#pragma unroll
                for (int bj = 0; bj < 2; ++bj) {
                    const int col0 = u.pn * 256 + bj * 128 + wc * 32 + fq * 8;
                    *(f32x4*)(out + row2 * D + col0) = acc[ai][bj][m][0] * rs * gv[bj][0]; *(f32x4*)(out + row2 * D + col0 + 4) = acc[ai][bj][m][1] * rs * gv[bj][1];
                }
            }
    }
};

#define XB_TMO      128
#define XB_XCNT(j)  (256  + 64 * (j))
#define XB_XSUB(j)  (1280 + 64 * (j))
#define XB_XGEN(j)  (2304 + 64 * (j))
#define XB_TOP      3328
#define XB_TOPGEN   3392
#define XCD_BAR_WORDS 3456
#define XB_SPIN_CAP (1u << 18)

__device__ __forceinline__ unsigned xb_ld(unsigned* p)              { return __hip_atomic_load(p, __ATOMIC_RELAXED, __HIP_MEMORY_SCOPE_AGENT); }
__device__ __forceinline__ unsigned xb_add(unsigned* p, unsigned v) { return __hip_atomic_fetch_add(p, v, __ATOMIC_RELAXED, __HIP_MEMORY_SCOPE_AGENT); }
__device__ __forceinline__ unsigned xb_xcc_id() { return (unsigned)__builtin_amdgcn_s_getreg((3 << 11) | 20) & 0xFu; }
#define XB_SPIN(cond, bar) do { unsigned _sp = 0; while (cond) { __builtin_amdgcn_s_sleep(1); \
    if ((++_sp & 255u) == 0u) { if (xb_ld(&(bar)[XB_TMO])) break; if (_sp > XB_SPIN_CAP) { atomicAdd(&(bar)[XB_TMO], 1u); break; } } } } while (0)

struct XcdBarrier {
    unsigned* bar; unsigned x;
    volatile LAS unsigned* st;
};

__device__ __forceinline__ XcdBarrier xcd_barrier_post(unsigned* bar, volatile LAS unsigned* st) {
    XcdBarrier b; b.bar = bar; b.x = xb_xcc_id(); b.st = st;
    if (threadIdx.x == 0) (void)xb_add(&bar[XB_XCNT(b.x)], 1u);
    return b;
}
__device__ __forceinline__ void xcd_barrier_complete(unsigned* bar, unsigned x, unsigned& nloc, unsigned& nx) {
    const unsigned G = gridDim.x * gridDim.y * gridDim.z;
    unsigned sum, cnt, mine, sp = 0u;
    for (;;) {
        sum = 0u; cnt = 0u; mine = 0u;
#pragma unroll
        for (unsigned j = 0; j < 16; ++j) { const unsigned c = xb_ld(&bar[XB_XCNT(j)]); sum += c; cnt += (c > 0u) ? 1u : 0u; mine = (j == x) ? c : mine; }
        if (sum == G) break;
        __builtin_amdgcn_s_sleep(1);
        if ((++sp & 255u) == 0u) { if (xb_ld(&bar[XB_TMO])) break; if (sp > XB_SPIN_CAP) { atomicAdd(&bar[XB_TMO], 1u); break; } }
    }
    nloc = mine > 0u ? mine : 1u; nx = cnt > 0u ? cnt : 1u;
}

__device__ __forceinline__ void xcd_barrier(const XcdBarrier& b) {
    asm volatile("s_waitcnt vmcnt(0)" ::: "memory");
    __syncthreads();
    if (threadIdx.x == 0) {
        unsigned* bar = b.bar;
        __builtin_amdgcn_s_waitcnt(0);
        unsigned nloc = b.st[0], nx = b.st[1];
        if (nloc == 0u) { xcd_barrier_complete(bar, b.x, nloc, nx); b.st[0] = nloc; b.st[1] = nx; }
        const unsigned old = xb_add(&bar[XB_XSUB(b.x)], 1u);
        const unsigned gen = old / nloc;
        if (old + 1u == (gen + 1u) * nloc) {
            __builtin_amdgcn_fence(__ATOMIC_RELEASE, "agent");
            asm volatile("s_waitcnt vmcnt(0)" ::: "memory");
            const unsigned og = xb_add(&bar[XB_TOP], 1u);
            const unsigned tg = og / nx;
            if (og + 1u == (tg + 1u) * nx) xb_add(&bar[XB_TOPGEN], 1u);
            else XB_SPIN(xb_ld(&bar[XB_TOPGEN]) == tg, bar);
            __builtin_amdgcn_fence(__ATOMIC_ACQUIRE, "agent");
            xb_add(&bar[XB_XGEN(b.x)], 1u);
            asm volatile("s_waitcnt vmcnt(0)" ::: "memory");
        } else {
            XB_SPIN(xb_ld(&bar[XB_XGEN(b.x)]) == gen, bar);
            __builtin_amdgcn_fence(__ATOMIC_ACQUIRE, "agent");
            asm volatile("s_waitcnt vmcnt(0)" ::: "memory");
        }
    }
    __syncthreads();
}


struct DepOrder : pg8::StaticOrder {
    unsigned* wait_ctr; unsigned wait_need; int wait_pm; unsigned* done_ctr; int done_pm;
    bool done_rel = true;
    int rot = 0;
    __device__ __forceinline__ bool next(int i, Unit& u) const {
        const int span = lim - L_off, n_c = span / G + (c < span % G ? 1 : 0); if (i >= n_c) return false;
        return pg8::StaticOrder::next(rot ? (i + rot) % n_c : i, u);
    }
    __device__ __forceinline__ void a_ready(const Unit& u) const {
        if (wait_pm == -2 || (wait_pm >= 0 && u.pm != wait_pm)) return;
        if (threadIdx.x < 64) {
            unsigned sp = 0;
            while ((unsigned)__builtin_amdgcn_readfirstlane(__hip_atomic_load(wait_ctr, __ATOMIC_RELAXED, __HIP_MEMORY_SCOPE_AGENT)) < wait_need) { __builtin_amdgcn_s_sleep(2); if (++sp > (1u << 21)) break; }
            __builtin_amdgcn_fence(__ATOMIC_ACQUIRE, "agent");
            asm volatile("s_waitcnt vmcnt(0)" ::: "memory");
        }
        asm volatile("" ::: "memory"); __builtin_amdgcn_s_barrier(); asm volatile("" ::: "memory");
    }
    __device__ __forceinline__ void done(const Unit& u) const {
        if (done_pm == -2 || (done_pm >= 0 && u.pm != done_pm)) return;
        asm volatile("s_waitcnt vmcnt(0)" ::: "memory");
        asm volatile("" ::: "memory"); __builtin_amdgcn_s_barrier(); asm volatile("" ::: "memory");
        if (threadIdx.x < 64) {
            if (done_rel) { __builtin_amdgcn_fence(__ATOMIC_RELEASE, "agent"); asm volatile("s_waitcnt vmcnt(0)" ::: "memory"); }
            if (threadIdx.x == 0) __hip_atomic_fetch_add(done_ctr, 1u, __ATOMIC_RELAXED, __HIP_MEMORY_SCOPE_AGENT);
        }
    }
};

struct Args { const float* in[26]; float* out; unsigned char* ws; };

typedef const __attribute__((address_space(4))) Args* KArgs;
__device__ __forceinline__ KArgs kargs() { KArgs p = (KArgs)__builtin_amdgcn_kernarg_segment_ptr(); asm volatile("" : "+s"(p)); return p; }
#define KIN(i) ((const float*)k->in[i])
#define WSP(T, off) ((T*)(k->ws + (off)))
__device__ __forceinline__ f32x2 cmul(f32x2 a, f32x2 b) { return (f32x2){a.x * b.x - a.y * b.y, a.x * b.y + a.y * b.x}; }
__device__ __forceinline__ f32x2 cexp_(float re, float im) { float s, c; sincosf(im, &s, &c); const float e = expf(re); return (f32x2){e * c, e * s}; }
__device__ __forceinline__ f32x2 zoh_coef(float are, float aim, float dt) {
    const f32x2 ab = cexp_(dt * are, dt * aim); const float nr = ab.x - 1.0f, ni = ab.y, den = 1.0f / (are * are + aim * aim);
    return (f32x2){(nr * are + ni * aim) * den, (ni * are - nr * aim) * den};
}

__device__ __forceinline__ void transpose_item(const float* W, int N, bf16* WT, int ldt, int k0, int n0, int src_n0, const float* gk, LAS float* scr, int lane) {
    float wv[32];
#pragma unroll
    for (int i = 0; i < 32; ++i) { const int kk = 2 * i + (lane >> 5); wv[i] = __builtin_nontemporal_load(W + (size_t)(k0 + kk) * N + src_n0 + (lane & 31)); }
    if (gk) {
#pragma unroll
        for (int i = 0; i < 32; ++i) wv[i] *= gk[k0 + 2 * i + (lane >> 5)];
    }
#pragma unroll
    for (int i = 0; i < 32; ++i) scr[(2 * i + (lane >> 5)) * 33 + (lane & 31)] = wv[i];
    LDS_WAIT(); asm volatile("" ::: "memory");
    const int c = lane & 7;
#pragma unroll
    for (int j = 0; j < 4; ++j) { const int n = (lane >> 3) + 8 * j; const LAS float* s = scr + (8 * c) * 33 + n;
        v4u o; o.x = cvt_pk_bf16(s[0 * 33], s[1 * 33]); o.y = cvt_pk_bf16(s[2 * 33], s[3 * 33]); o.z = cvt_pk_bf16(s[4 * 33], s[5 * 33]); o.w = cvt_pk_bf16(s[6 * 33], s[7 * 33]);
        *(v4u*)(WT + (size_t)(n0 + n) * ldt + k0 + 8 * c) = o; }
    LDS_WAIT(); asm volatile("" ::: "memory");
}

__global__ void __launch_bounds__(512, 2) fwd_kernel(Args a) {
    extern __shared__ __attribute__((aligned(16))) unsigned char lds_raw[];
    LAS unsigned char* lds = (LAS unsigned char*)lds_raw;
    cg::grid_group grid = cg::this_grid();
    const int tid = threadIdx.x, lane = tid & 63, wave = __builtin_amdgcn_readfirstlane(tid >> 6);
    const int G = gridDim.x, bx = blockIdx.x;
    const int gw = bx * 8 + wave, NGW = G * 8;
    const size_t gt = (size_t)bx * 512 + tid, NGT = (size_t)G * 512;
    volatile LAS unsigned* MISC = (volatile LAS unsigned*)(lds + 131072 + 1024);
    if (tid < 16) MISC[tid] = 0u;
    __syncthreads();
    XcdBarrier xbar;
    { KArgs k = kargs(); if (k->ws == nullptr) grid.sync();
      xbar = xcd_barrier_post((unsigned*)(k->ws + WS_BAR), MISC + 8); }

    {
        KArgs k = kargs();
        const float* x_p = KIN(0); const float* x_s = KIN(1); const float* g_mix = KIN(6); const float* w_in = KIN(7); const float* a_re = KIN(8); const float* a_im = KIN(9); const float* log_dt = KIN(10);
        const float* b_re = KIN(11); const float* b_im = KIN(12); const float* w_glu = KIN(16);
        bf16* WIN = WSP(bf16, WS_WIN); bf16* WGLU = WSP(bf16, WS_WGLU); unsigned* CTR = WSP(unsigned, WS_CTR);
        f32x2* ABAR = WSP(f32x2, WS_ABAR); f32x2* AT = WSP(f32x2, WS_AT); f32x2* BBAR = WSP(f32x2, WS_BBAR); f32x2* APW = WSP(f32x2, WS_APW);
        float* SS = WSP(float, WS_SS); bf16* XN = WSP(bf16, WS_XN); float* RINV = WSP(float, WS_RINV);
        {
            LAS float* scr = (LAS float*)(lds + wave * 16384);
            constexpr int I_IN = 16 * 32, I_GLU = 8 * 16;
            for (int it = gw; it < I_IN + I_GLU; it += NGW) {
                int r = it;
                if (r < I_IN) { const int kb = r / 32, nb = r % 32; transpose_item(w_in, D, WIN, D, 64 * kb, 32 * nb, 32 * nb, nullptr, scr, lane); continue; } r -= I_IN;
                { const int kb = r / 16, nb = r % 16; transpose_item(w_glu, 512, WGLU, 512, 64 * kb, 32 * nb, 32 * nb, nullptr, scr, lane); }
            }
        }
        auto xn_rows2 = [&](int m) {
            v2u* o8 = (v2u*)(XN + (size_t)m * D) + lane;
            if (m < MTOT) {
                const float* xr = m < MP ? x_p + (size_t)m * D : x_s + (size_t)(m - MP) * D;
                const f32x4* xr4 = (const f32x4*)xr + lane;
                f32x4 v[2][4]; float sq0 = 0.f, sq1 = 0.f;
#pragma unroll
                for (int j = 0; j < 4; ++j) { v[0][j] = __builtin_nontemporal_load(xr4 + 64 * j); v[1][j] = __builtin_nontemporal_load(xr4 + 256 + 64 * j); }
#pragma unroll
                for (int j = 0; j < 4; ++j) { sq0 += (v[0][j][0] * v[0][j][0] + v[0][j][1] * v[0][j][1]) + (v[0][j][2] * v[0][j][2] + v[0][j][3] * v[0][j][3]);
                                              sq1 += (v[1][j][0] * v[1][j][0] + v[1][j][1] * v[1][j][1]) + (v[1][j][2] * v[1][j][2] + v[1][j][3] * v[1][j][3]); }
                const float ms0 = wave_sum(sq0) * (1.0f / D) + EPS, ms1 = wave_sum(sq1) * (1.0f / D) + EPS; const float rs0 = rsqrtf(ms0), rs1 = rsqrtf(ms1);
                if (lane == 0) { RINV[m] = sqrtf(ms0); RINV[m + 1] = sqrtf(ms1); }
#pragma unroll
                for (int j = 0; j < 4; ++j) { const f32x4 gq = ((const f32x4*)g_mix)[lane + 64 * j]; const f32x4 y0 = v[0][j] * rs0 * gq, y1 = v[1][j] * rs1 * gq;
                    v2u w; w.x = cvt_pk_bf16(y0[0], y0[1]); w.y = cvt_pk_bf16(y0[2], y0[3]); o8[64 * j] = w;
                    v2u w1; w1.x = cvt_pk_bf16(y1[0], y1[1]); w1.y = cvt_pk_bf16(y1[2], y1[3]); o8[256 + 64 * j] = w1; }
            } else {
#pragma unroll
                for (int j = 0; j < 4; ++j) { o8[64 * j] = (v2u){0u, 0u}; o8[256 + 64 * j] = (v2u){0u, 0u}; }
            }
        };
        auto xn_row1 = [&](int m) {
            v2u* o8 = (v2u*)(XN + (size_t)m * D) + lane;
            if (m < MTOT) {
                const float* xr = m < MP ? x_p + (size_t)m * D : x_s + (size_t)(m - MP) * D;
                const f32x4* xr4 = (const f32x4*)xr + lane;
                f32x4 v[4]; float sq = 0.f;
#pragma unroll
                for (int j = 0; j < 4; ++j) v[j] = xr4[64 * j];
#pragma unroll
                for (int j = 0; j < 4; ++j) sq += (v[j][0] * v[j][0] + v[j][1] * v[j][1]) + (v[j][2] * v[j][2] + v[j][3] * v[j][3]);
                const float ms = wave_sum(sq) * (1.0f / D) + EPS; const float rs = rsqrtf(ms);
                if (lane == 0) RINV[m] = sqrtf(ms);
#pragma unroll
                for (int j = 0; j < 4; ++j) { const f32x4 gq = ((const f32x4*)g_mix)[lane + 64 * j]; const f32x4 y = v[j] * rs * gq;
                    v2u w; w.x = cvt_pk_bf16(y[0], y[1]); w.y = cvt_pk_bf16(y[2], y[3]); o8[64 * j] = w; }
            } else {
#pragma unroll
                for (int j = 0; j < 4; ++j) o8[64 * j] = (v2u){0u, 0u};
            }
        };
        {
            for (size_t i = gt; i < (size_t)MPAD; i += NGT) SS[i] = 0.f;
            for (int it = bx; it * 8 < NG * NP; it += G) if (tid < 8) {
                const size_t i = (size_t)it * 8 + tid;
                const int g = (int)i / NP; const float dt = expf(log_dt[g]); const float are = a_re[i], aim = a_im[i];
                f32x4 br[4], bi[4];
#pragma unroll
                for (int q = 0; q < 4; ++q) { br[q] = *(const f32x4*)(b_re + i * NH + 4 * q); bi[q] = *(const f32x4*)(b_im + i * NH + 4 * q); }
                const f32x2 ab = cexp_(dt * are, dt * aim); f32x2 pw = (f32x2){1.f, 0.f};
#pragma unroll
                for (int q = 0; q <= 16; ++q) { APW[i * 17 + q] = pw; if (q == 16) AT[i] = pw; pw = cmul(pw, ab); }
                ABAR[i] = ab;
                const float nr = ab.x - 1.0f, ni = ab.y, den = 1.0f / (are * are + aim * aim);
                const f32x2 cf = (f32x2){(nr * are + ni * aim) * den, (ni * are - nr * aim) * den};
#pragma unroll
                for (int h = 0; h < NH; ++h) BBAR[i * NH + h] = cmul(cf, (f32x2){br[h >> 2][h & 3], bi[h >> 2][h & 3]});
            }
            for (int m = 2 * gw; m < MP; m += 2 * NGW) xn_rows2(m);
            if (wave == 7) for (int m = MP + bx; m < MPAD; m += G) xn_row1(m);
        }
    }
    xcd_barrier(xbar);

    {
        KArgs k = kargs();
        bf16* XN = WSP(bf16, WS_XN); bf16* WIN = WSP(bf16, WS_WIN); bf16* UPERM = WSP(bf16, WS_UPERM); float* USAMP = WSP(float, WS_USAMP); float* V = WSP(float, WS_V);
        pg8::Gemm g{XN, WIN, MP, D, D, D}; pg8::StaticOrder S; S.init(MP, D, G, bx);
        EpiProj Ep{UPERM, USAMP, V};
        pg8::gemm_phase<EpiProj, pg8::StaticOrder, true, true, 0>(lds, g, S, Ep);
    }
    if (bx < 64) {
        KArgs k = kargs();
        const bf16* XN = WSP(bf16, WS_XN); const bf16* WIN = WSP(bf16, WS_WIN); float* USAMP = WSP(float, WS_USAMP); float* V = WSP(float, WS_V);
        const int r16 = lane & 15, q4 = lane >> 4;
        f32x4 pa[8];
#pragma unroll
        for (int rbk = 0; rbk < 8; ++rbk) pa[rbk] = (f32x4){0.f, 0.f, 0.f, 0.f};
        const bf16* wp = WIN + ((size_t)(16 * bx + r16) * D + 128 * wave + 8 * q4);
        const bf16* ap = XN + ((size_t)(MP + r16) * D + 128 * wave + 8 * q4);
#pragma unroll
        for (int ks = 0; ks < 4; ++ks) {
            const bf16x8 wf = *(const bf16x8*)(wp + 32 * ks);
#pragma unroll
            for (int rbk = 0; rbk < 8; ++rbk) { const bf16x8 af = *(const bf16x8*)(ap + (size_t)rbk * 16 * D + 32 * ks); pa[rbk] = __builtin_amdgcn_mfma_f32_16x16x32_bf16(wf, af, pa[rbk], 0, 0, 0); }
        }
        LAS f32x4* red = (LAS f32x4*)lds;
#pragma unroll
        for (int rbk = 0; rbk < 8; ++rbk) red[(wave * 8 + rbk) * 64 + lane] = pa[rbk];
        __syncthreads();
        f32x4 t = (f32x4){0.f, 0.f, 0.f, 0.f};
#pragma unroll
        for (int w2 = 0; w2 < 8; ++w2) t += red[(w2 * 8 + wave) * 64 + lane];
        const int ns = 16 * wave + r16, col = 16 * bx + 4 * q4;
        if (col < 512) *(f32x4*)(USAMP + (size_t)ns * 512 + col) = t; else *(f32x4*)(V + (size_t)(MP + ns) * 512 + (col - 512)) = t;
        __syncthreads();
    } else
    {
        KArgs k = kargs();
        const float* c_re = KIN(13); const float* c_im = KIN(14); const float* s5_d = KIN(15);
        bf16* KTAB = WSP(bf16, WS_KTAB); bf16* W2 = WSP(bf16, WS_W2); bf16* W3 = WSP(bf16, WS_W3); const f32x2* BBAR = WSP(f32x2, WS_BBAR); const f32x2* APW = WSP(f32x2, WS_APW);
        const size_t vt = (size_t)(bx - 64) * 512 + tid, VNT = (size_t)(G - 64) * 512;
        for (size_t i = vt; i < (size_t)NG * 16 * 64; i += VNT) {
            const int hq = (int)i & 3, h = ((int)i >> 2) & 15, lag = ((int)i >> 6) & 15, g = (int)i >> 10;
            float s0 = 0.f, s1 = 0.f, s2 = 0.f, s3 = 0.f;
            const float* crp = c_re + (size_t)(g * NH + h) * NP; const float* cip = c_im + (size_t)(g * NH + h) * NP;
#pragma unroll 8
            for (int p = 0; p < NP; ++p) {
                const int gp = g * NP + p;
                const f32x2 ac = cmul(APW[gp * 17 + lag], (f32x2){crp[p], cip[p]});
                const f32x4 b01 = *(const f32x4*)(BBAR + (size_t)gp * NH + 4 * hq), b23 = *(const f32x4*)(BBAR + (size_t)gp * NH + 4 * hq + 2);
                s0 += ac.x * b01[0] - ac.y * b01[1]; s1 += ac.x * b01[2] - ac.y * b01[3]; s2 += ac.x * b23[0] - ac.y * b23[1]; s3 += ac.x * b23[2] - ac.y * b23[3];
            }
            if (lag == 0 && (h >> 2) == hq) { const float dd = s5_d[g * NH + h]; if ((h & 3) == 0) s0 += dd; else if ((h & 3) == 1) s1 += dd; else if ((h & 3) == 2) s2 += dd; else s3 += dd; }
            v2u w; w.x = cvt_pk_bf16(s0, s1); w.y = cvt_pk_bf16(s2, s3);
            *(v2u*)(KTAB + i * 4) = w;
        }
        for (size_t i = vt; i < (size_t)NG * NP * 16; i += VNT) {
            const int j = (int)i & 15, p = ((int)i >> 4) & 63, g = (int)i >> 10; const int gp = g * NP + p;
            const f32x2 cf = APW[gp * 17 + 15 - j];
            unsigned wre[8], wim[8];
#pragma unroll
            for (int h = 0; h < NH; h += 2) {
                const f32x4 b2 = *(const f32x4*)(BBAR + (size_t)gp * NH + h);
                const f32x2 v0 = cmul(cf, (f32x2){b2[0], b2[1]}), v1 = cmul(cf, (f32x2){b2[2], b2[3]});
                wre[h >> 1] = cvt_pk_bf16(v0.x, v1.x); wim[h >> 1] = cvt_pk_bf16(v0.y, v1.y);
            }
            bf16* w2r = W2 + ((size_t)(g * 128 + 2 * p) * 256 + j * 16);
            *(v4u*)(w2r) = (v4u){wre[0], wre[1], wre[2], wre[3]}; *(v4u*)(w2r + 8) = (v4u){wre[4], wre[5], wre[6], wre[7]};
            *(v4u*)(w2r + 256) = (v4u){wim[0], wim[1], wim[2], wim[3]}; *(v4u*)(w2r + 264) = (v4u){wim[4], wim[5], wim[6], wim[7]};
        }
        for (size_t i = vt; i < (size_t)NG * 16 * 16 * 16; i += VNT) {
            const int pq = (int)i & 15, h = ((int)i >> 4) & 15, j = ((int)i >> 8) & 15, g = (int)i >> 12;
            const f32x4 cr4 = *(const f32x4*)(c_re + (size_t)(g * NH + h) * NP + 4 * pq), ci4 = *(const f32x4*)(c_im + (size_t)(g * NH + h) * NP + 4 * pq);
            unsigned w[4];
#pragma unroll
            for (int q = 0; q < 4; ++q) { const f32x2 v = cmul(APW[(g * NP + 4 * pq + q) * 17 + j + 1], (f32x2){cr4[q], ci4[q]}); w[q] = cvt_pk_bf16(v.x, -v.y); }
            *(v4u*)(W3 + ((size_t)(g * 256 + j * 16 + h) * 128 + 8 * pq)) = (v4u){w[0], w[1], w[2], w[3]};
        }
    }
    xcd_barrier(xbar);

    {
        KArgs k = kargs();
        float* out = k->out;
        const bf16* UPERM = WSP(bf16, WS_UPERM); const bf16* W2 = WSP(bf16, WS_W2); const bf16* KTAB = WSP(bf16, WS_KTAB); const bf16* W3 = WSP(bf16, WS_W3); bf16* YG = WSP(bf16, WS_YG);
        const f32x2* AT = WSP(f32x2, WS_AT);
        const int r16 = lane & 15, q4 = lane >> 4;
        LAS unsigned char* EbB = lds;
        LAS unsigned char* W2S = lds + 65536;
        LAS unsigned char* W3S = lds;
        LAS bf16* hl = (LAS bf16*)(lds + 69632 + wave * 4352);
        LAS bf16* ktl = (LAS bf16*)(lds + 133120);
        for (int task = bx; task < NG * NB; task += G) {
            const int g = task >> 3, nb = task & 7, rb = nb * 8 + wave, c0 = 16 * wave;
            const bf16* up = UPERM + ((size_t)(g * NROW + rb * 16 + r16) * 256 + 8 * q4);
            *(LAS v4u*)(ktl + tid * 8) = *(const v4u*)(KTAB + (size_t)g * 4096 + tid * 8);
            {
                const bf16* w2g = W2 + (size_t)g * 128 * 256;
                v4u tv[8];
#pragma unroll
                for (int ii = 0; ii < 8; ++ii) tv[ii] = *(const v4u*)(w2g + (size_t)(tid + 512 * ii) * 8);
#pragma unroll
                for (int ii = 0; ii < 8; ++ii) { const int idx = tid + 512 * ii, q = idx >> 5, c16 = idx & 31; *(LAS v4u*)(W2S + q * 512 + ((c16 ^ (q & 15)) << 4)) = tv[ii]; }
            }
            __syncthreads();
            {
                f32x4 ea[8];
#pragma unroll
                for (int cb = 0; cb < 8; ++cb) ea[cb] = (f32x4){0.f, 0.f, 0.f, 0.f};
                bf16x8 ufr[8];
#pragma unroll
                for (int ks = 0; ks < 8; ++ks) ufr[ks] = *(const bf16x8*)(up + 32 * ks);
#pragma unroll
                for (int ks = 0; ks < 8; ++ks)
#pragma unroll
                    for (int cb = 0; cb < 8; ++cb) { const bf16x8 wf = *(const LAS bf16x8*)(W2S + (cb * 16 + r16) * 512 + (((4 * ks + q4) ^ r16) << 4)); ea[cb] = __builtin_amdgcn_mfma_f32_16x16x32_bf16(wf, ufr[ks], ea[cb], 0, 0, 0); }
#pragma unroll
                for (int cb = 0; cb < 8; ++cb) *(LAS f32x4*)(EbB + (c0 + r16) * 512 + (((4 * cb + q4) ^ r16) << 4)) = ea[cb];
            }
            __syncthreads();
            {
                const f32x2 aT = AT[g * NP + lane]; f32x2 S = (f32x2){0.f, 0.f};
                const int ch = lane >> 1, wo = (lane & 1) * 8;
                for (int c = 0; c < c0; c += 16) {
                    f32x2 ev[16];
#pragma unroll
                    for (int q = 0; q < 16; ++q) ev[q] = *(const LAS f32x2*)(EbB + (c + q) * 512 + ((ch ^ q) << 4) + wo);
#pragma unroll
                    for (int q = 0; q < 16; ++q) S = cmul(aT, S) + ev[q];
                }
#pragma unroll
                for (int cc = 0; cc < 16; ++cc) {
                    *(LAS unsigned*)(hl + cc * 136 + 2 * lane) = cvt_pk_bf16(S.x, S.y);
                    const f32x2 e = *(const LAS f32x2*)(EbB + (c0 + cc) * 512 + ((ch ^ cc) << 4) + wo); S = cmul(aT, S) + e;
                }
                if (wave == 7) { out[O_PRE + (size_t)nb * 2048 + g * NP + lane] = S.x; out[O_PIM + (size_t)nb * 2048 + g * NP + lane] = S.y; }
            }
            __syncthreads();
            {
                const bf16* w3g = W3 + (size_t)g * 256 * 128;
                v4u tv[8];
#pragma unroll
                for (int ii = 0; ii < 8; ++ii) tv[ii] = *(const v4u*)(w3g + (size_t)(tid + 512 * ii) * 8);
#pragma unroll
                for (int ii = 0; ii < 8; ++ii) { const int idx = tid + 512 * ii, jr = idx >> 4, c16 = idx & 15; *(LAS v4u*)(W3S + jr * 256 + ((c16 ^ (jr & 15)) << 4)) = tv[ii]; }
            }
            f32x4 acc[16];
#pragma unroll
            for (int cb = 0; cb < 16; ++cb) acc[cb] = (f32x4){0.f, 0.f, 0.f, 0.f};
            const LAS bf16* kt2 = ktl + (r16 * 16 + 8 * (q4 & 1)) - (q4 >> 1) * 256;
#pragma unroll
            for (int kr = 0; kr < 4; ++kr) {
                bf16x8 ufr[2], wfr[2][16];
#pragma unroll
                for (int kk = 0; kk < 2; ++kk) { const int ks = 2 * kr + kk; ufr[kk] = *(const bf16x8*)(up + 32 * ks);
#pragma unroll
                    for (int cb = 0; cb < 16; ++cb) if (2 * ks <= cb) {
                        wfr[kk][cb] = *(const LAS bf16x8*)(kt2 + (cb - 2 * ks) * 256);
                        if (cb == 2 * ks && (q4 >> 1)) wfr[kk][cb] = (bf16x8){0, 0, 0, 0, 0, 0, 0, 0};
                    } }
#pragma unroll
                for (int kk = 0; kk < 2; ++kk) { const int ks = 2 * kr + kk;
#pragma unroll
                    for (int cb = 0; cb < 16; ++cb) if (2 * ks <= cb) acc[cb] = __builtin_amdgcn_mfma_f32_16x16x32_bf16(wfr[kk][cb], ufr[kk], acc[cb], 0, 0, 0); }
                asm volatile("" ::: "memory");
            }
            __syncthreads();
#pragma unroll
            for (int ks = 0; ks < 4; ++ks) {
                const bf16x8 hf = *(const LAS bf16x8*)(hl + r16 * 136 + 32 * ks + 8 * q4);
#pragma unroll
                for (int cb = 0; cb < 16; ++cb) { const bf16x8 wf = *(const LAS bf16x8*)(W3S + (cb * 16 + r16) * 256 + (((4 * ks + q4) ^ r16) << 4)); acc[cb] = __builtin_amdgcn_mfma_f32_16x16x32_bf16(wf, hf, acc[cb], 0, 0, 0); }
            }
            const int row = rb * 16 + r16, c = row & 127;
            bf16* yp = YG + ((size_t)(nb * L + c * 16) * 512 + g * 16 + 4 * q4);
#pragma unroll
            for (int cb = 0; cb < 16; ++cb) {
                const f32x4 y = gelu4(acc[cb]);
                v2u wv; wv.x = cvt_pk_bf16(y[0], y[1]); wv.y = cvt_pk_bf16(y[2], y[3]);
                *(v2u*)(yp + (size_t)cb * 512) = wv;
            }
            __syncthreads();
        }
    }
    {
        KArgs k = kargs();
        float* out = k->out; const float* V = WSP(float, WS_V); bf16* AMIX = WSP(bf16, WS_AMIX); bf16* YG = WSP(bf16, WS_YG);
        for (size_t i = gt; i < (size_t)(MP / 8) * 128; i += NGT) {
            const int rb8 = (int)(i >> 7), c4 = (int)(i & 127) * 4, gi = c4 >> 7, w = 2 << gi;
            const int row0 = rb8 * 8, tl0 = row0 & (L - 1);
            const float* vp = V + (size_t)row0 * 512 + c4;
            f32x4 r[23];
#pragma unroll
            for (int j = 0; j < 23; ++j) { r[j] = (f32x4){0.f, 0.f, 0.f, 0.f}; if (tl0 + j - 15 >= 0) r[j] = *(const f32x4*)(vp + (ptrdiff_t)(j - 15) * 512); }
#pragma unroll
            for (int j = 0; j < 8; ++j) {
                const int tl = tl0 + j; const int cnt = (tl + 1) < w ? (tl + 1) : w;
                f32x4 sm = r[15 + j];
#pragma unroll
                for (int q = 1; q < 16; ++q) if (q < w) sm += r[15 + j - q];
                const f32x4 o = sm * (1.0f / (float)cnt) - r[15 + j];
                if (tl >= L - 15) *(f32x4*)(out + O_PPOOL + ((size_t)(((row0 + j) >> 11) * 15 + (tl - (L - 15))) * 512 + c4)) = r[15 + j];
                v2u wv; wv.x = cvt_pk_bf16(o[0], o[1]); wv.y = cvt_pk_bf16(o[2], o[3]);
                *(v2u*)(AMIX + (size_t)(row0 + j) * D + 512 + c4) = wv;
            }
        }
        for (size_t i = gt; i < (size_t)(MPAD - MTOT) * 512 / 8; i += NGT) *(v4u*)(YG + (size_t)MTOT * 512 + i * 8) = (v4u){0u, 0u, 0u, 0u};
        {
            const float* g_ffn = KIN(20); const float* w_up = KIN(21); bf16* WUP = WSP(bf16, WS_WUP);
            LAS float* scr = (LAS float*)(lds + wave * 16384);
            for (int r = gw; r < 16 * 176; r += NGW) { const int kb = r / 176, nb = r % 176; const int n0 = 32 * nb, pn = n0 >> 8, lr = n0 & 255; const int src = lr < 128 ? 128 * pn + lr : FF + 128 * pn + (lr - 128);
                transpose_item(w_up, FF2, WUP, D, 64 * kb, n0, src, g_ffn, scr, lane); }
        }
    }
    {
        KArgs k = kargs();
        float* out = k->out; const float* st_re = KIN(2); const float* st_im = KIN(3); const float* st_pool = KIN(4); const float* c_re = KIN(13); const float* c_im = KIN(14); const float* s5_d = KIN(15);
        const float* V = WSP(float, WS_V); bf16* AMIX = WSP(bf16, WS_AMIX); const float* USAMP = WSP(float, WS_USAMP); const f32x2* ABAR = WSP(f32x2, WS_ABAR); const f32x2* BBAR = WSP(f32x2, WS_BBAR); bf16* YG = WSP(bf16, WS_YG);
        for (int task = gw; task < NS * NG; task += NGW) {
            const int ns = task >> 5, g = task & 31; const int gp = g * NP + lane;
            const float* ur = USAMP + (size_t)ns * 512 + g * 16;
            float uu[NH];
#pragma unroll
            for (int h = 0; h < NH; ++h) uu[h] = ur[h];
            f32x2 bu = (f32x2){0.f, 0.f};
#pragma unroll
            for (int h = 0; h < NH; ++h) { const f32x2 bb = BBAR[(size_t)gp * NH + h]; bu.x += bb.x * uu[h]; bu.y += bb.y * uu[h]; }
            const f32x2 h0 = (f32x2){st_re[(size_t)ns * 2048 + gp], st_im[(size_t)ns * 2048 + gp]};
            const f32x2 hn = cmul(ABAR[gp], h0) + bu;
            out[O_SRE + (size_t)ns * 2048 + gp] = hn.x; out[O_SIM + (size_t)ns * 2048 + gp] = hn.y;
            float cr[NH], ci[NH];
#pragma unroll
            for (int h = 0; h < NH; ++h) { cr[h] = c_re[(size_t)(g * NH + h) * NP + lane]; ci[h] = c_im[(size_t)(g * NH + h) * NP + lane]; }
            float t[NH];
#pragma unroll
            for (int h = 0; h < NH; ++h) t[h] = cr[h] * hn.x - ci[h] * hn.y;
            const bool b5 = (lane & 32) != 0, b4 = (lane & 16) != 0, b3 = (lane & 8) != 0, b2 = (lane & 4) != 0;
            float ra[8], rb[4], rc[2];
#pragma unroll
            for (int i = 0; i < 8; ++i) { const float keep = b5 ? t[i + 8] : t[i], send = b5 ? t[i] : t[i + 8]; ra[i] = keep + __shfl_xor(send, 32); }
#pragma unroll
            for (int i = 0; i < 4; ++i) { const float keep = b4 ? ra[i + 4] : ra[i], send = b4 ? ra[i] : ra[i + 4]; rb[i] = keep + __shfl_xor(send, 16); }
#pragma unroll
            for (int i = 0; i < 2; ++i) { const float keep = b3 ? rb[i + 2] : rb[i], send = b3 ? rb[i] : rb[i + 2]; rc[i] = keep + __shfl_xor(send, 8); }
            float rd; { const float keep = b2 ? rc[1] : rc[0], send = b2 ? rc[0] : rc[1]; rd = keep + __shfl_xor(send, 4); }
            rd += __shfl_xor(rd, 2); rd += __shfl_xor(rd, 1);
            const int hsel = (b5 ? 8 : 0) + (b4 ? 4 : 0) + (b3 ? 2 : 0) + (b2 ? 1 : 0);
            const float my = rd + s5_d[g * NH + hsel] * ur[hsel];
            if ((lane & 3) == 0) YG[(size_t)(MP + ns) * 512 + g * 16 + hsel] = (bf16)(cvt_pk_bf16(gelu_exact(my), 0.f) & 0xffffu);
        }
        for (size_t i = gt; i < (size_t)(MPAD - MP) * 128; i += NGT) {
            const int row = MP + (int)(i >> 7), c4 = (int)(i & 127) * 4, gi = c4 >> 7, w = 2 << gi;
            f32x4 o = (f32x4){0.f, 0.f, 0.f, 0.f};
            if (row < MTOT) {
                const int ns = row - MP;
                const f32x4 vt4 = *(const f32x4*)(V + (size_t)row * 512 + c4); f32x4 s = vt4;
                f32x4 bq[15];
#pragma unroll
                for (int q = 1; q < 16; ++q) bq[q - 1] = *(const f32x4*)(st_pool + ((size_t)(ns * 15 + 15 - q) * 512 + c4));
#pragma unroll
                for (int q = 1; q < 16; ++q) if (q < w) s += bq[q - 1];
                o = s * (1.0f / (float)w) - vt4;
                *(f32x4*)(out + O_SPOOL + ((size_t)(ns * 15 + 14) * 512 + c4)) = vt4;
#pragma unroll
                for (int r = 0; r < 14; ++r) *(f32x4*)(out + O_SPOOL + ((size_t)(ns * 15 + r) * 512 + c4)) = bq[13 - r];
            }
            v2u wv; wv.x = cvt_pk_bf16(o[0], o[1]); wv.y = cvt_pk_bf16(o[2], o[3]);
            *(v2u*)(AMIX + (size_t)row * D + 512 + c4) = wv;
        }
    }
    xcd_barrier(xbar);

    {
        KArgs k = kargs();
        bf16* YG = WSP(bf16, WS_YG); bf16* WGLU = WSP(bf16, WS_WGLU); bf16* AMIX = WSP(bf16, WS_AMIX);
        pg8::Gemm g{YG, WGLU, MPAD, 512, 512, 512}; pg8::StaticOrder S; S.init(MPAD, 512, G, bx);
        EpiGlu Ep{YG, AMIX};
        pg8::gemm_phase<EpiGlu, pg8::StaticOrder, true, true, 0>(lds, g, S, Ep);
    }
    if (bx >= 194) {
        KArgs k = kargs();
        const float* w_out = KIN(19); const float* w_down = KIN(24);
        bf16* WMIX = WSP(bf16, WS_WMIX); bf16* WDN = WSP(bf16, WS_WDN);
        const int vw = (bx - 194) * 8 + wave, VNW = (G - 194) * 8;
        LAS float* scr = (LAS float*)(lds + wave * 16384);
        constexpr int I_OUT = 8 * 32, I_DN = 44 * 32;
        for (int it = vw; it < I_OUT + I_DN; it += VNW) {
            int r = it;
            if (r < I_OUT) { const int kb = r / 32, nb = r % 32; transpose_item(w_out, D, WMIX, D, 64 * kb, 32 * nb, 32 * nb, nullptr, scr, lane); continue; } r -= I_OUT;
            { const int kb = r / 32, nb = r % 32; transpose_item(w_down, D, WDN, FF, 64 * kb, 32 * nb, 32 * nb, nullptr, scr, lane); }
        }
    } else if (bx >= 130) {
        KArgs k = kargs();
        const float* pool_w = KIN(17); const float* pool_scale = KIN(18); const float* w_out = KIN(19); bf16* WMIX = WSP(bf16, WS_WMIX);
        const size_t vt = (size_t)(bx - 130) * 512 + tid, VNT = (size_t)64 * 512;
        for (size_t i = vt; i < (size_t)128 * 256; i += VNT) {
            const int n4 = (int)(i & 255) * 4, gc0 = (int)(i >> 8) * 4, g = gc0 >> 7;
            const float* pw = pool_w + (size_t)gc0 * 128; const float* sc = pool_scale + g * 128; const float* wo = w_out + (size_t)(512 + g * 128) * D + n4;
            f32x4 s0 = (f32x4){0.f, 0.f, 0.f, 0.f}, s1 = s0, s2 = s0, s3 = s0;
#pragma unroll 16
            for (int d = 0; d < 128; ++d) {
                const f32x4 wv = *(const f32x4*)(wo + (size_t)d * D) * sc[d];
                s0 += wv * pw[d]; s1 += wv * pw[128 + d]; s2 += wv * pw[256 + d]; s3 += wv * pw[384 + d];
            }
#pragma unroll
            for (int e = 0; e < 4; ++e) {
                v2u w; w.x = cvt_pk_bf16(s0[e], s1[e]); w.y = cvt_pk_bf16(s2[e], s3[e]);
                *(v2u*)(WMIX + (size_t)(n4 + e) * D + 512 + gc0) = w;
            }
        }
    }
    xcd_barrier(xbar);

    {
        KArgs k = kargs();
        float* out = k->out; const float* x_p = KIN(0); const float* x_s = KIN(1); bf16* AMIX = WSP(bf16, WS_AMIX); bf16* WMIX = WSP(bf16, WS_WMIX); bf16* XMIDB = WSP(bf16, WS_XMIDB); float* SS = WSP(float, WS_SS);
        pg8::Gemm g{AMIX, WMIX, MP, D, D, D}; pg8::StaticOrder S; S.init(MP, D, G, bx);
        EpiOut Ep{x_p, x_s, out, XMIDB, SS, WSP(bf16, WS_XN), WSP(float, WS_RINV), KIN(6)};
        pg8::gemm_phase<EpiOut, pg8::StaticOrder, true, true, 0>(lds, g, S, Ep);
    }
    xcd_barrier(xbar);

    {
        KArgs k = kargs();
        bf16* XMIDB = WSP(bf16, WS_XMIDB); bf16* WUP = WSP(bf16, WS_WUP); float* SS = WSP(float, WS_SS); float* HALO = WSP(float, WS_HALO); unsigned* CTR = WSP(unsigned, WS_CTR);
        pg8::Gemm g{XMIDB - 2 * D, WUP, 512, FF2, D, D}; DepOrder S; S.init(512, FF2, G, bx); S.wait_ctr = CTR; S.wait_need = 0; S.wait_pm = -2; S.done_ctr = CTR; S.done_pm = -1; S.done_rel = false;
        EpiHalo Ep{SS, HALO};
        pg8::gemm_phase<EpiHalo, DepOrder, true, true, 1>(lds, g, S, Ep);
    }
    {
        KArgs k = kargs();
        float* out = k->out; const float* x_p = KIN(0); const float* x_s = KIN(1); bf16* AMIX = WSP(bf16, WS_AMIX); bf16* WMIX = WSP(bf16, WS_WMIX); bf16* XMIDB = WSP(bf16, WS_XMIDB); float* SS = WSP(float, WS_SS); unsigned* CTR = WSP(unsigned, WS_CTR);
        pg8::Gemm g{AMIX, WMIX, 256, D, D, D}; DepOrder S; S.init(256, D, G, (bx + G - 44) % G, 64); S.wait_ctr = CTR; S.wait_need = 0; S.wait_pm = -2; S.done_ctr = CTR + 64; S.done_pm = -1;
        EpiOut Ep{x_p, x_s, out, XMIDB, SS, nullptr, nullptr, nullptr};
        pg8::gemm_phase<EpiOut, DepOrder, true, true, 0>(lds, g, S, Ep);
    }
    {
        KArgs k = kargs();
        float* out = k->out; const float* conv_w = KIN(22); const float* conv_b = KIN(23); const float* st_conv = KIN(5); unsigned* CTR = WSP(unsigned, WS_CTR);
        bf16* XMIDB = WSP(bf16, WS_XMIDB); bf16* WUP = WSP(bf16, WS_WUP); float* SS = WSP(float, WS_SS); float* HALO = WSP(float, WS_HALO); bf16* ACT = WSP(bf16, WS_ACT);
        pg8::Gemm g{XMIDB, WUP, MPAD, FF2, D, D}; DepOrder S; S.init(MPAD, FF2, G, (bx + 150) % G);
        S.wait_ctr = CTR + 64; S.wait_need = 4; S.wait_pm = 64; S.done_ctr = CTR + 128; S.done_pm = 64; S.rot = 2;
        EpiUp Ep{ACT, SS, HALO, conv_w, conv_b, st_conv, out + O_PCONV, out + O_SCONV, CTR, 44u, 0};
        pg8::gemm_phase<EpiUp, DepOrder, true, true, 0>(lds, g, S, Ep);
    }
    if (bx >= 60 && bx < 92) {
        KArgs k = kargs();
        float* out = k->out; const bf16* ACT = WSP(bf16, WS_ACT); const bf16* WDN = WSP(bf16, WS_WDN); unsigned* CTR = WSP(unsigned, WS_CTR);
        if (tid < 64) { unsigned sp = 0;
            while ((unsigned)__builtin_amdgcn_readfirstlane(__hip_atomic_load(CTR + 128, __ATOMIC_RELAXED, __HIP_MEMORY_SCOPE_AGENT)) < 22u) { __builtin_amdgcn_s_sleep(8); if (++sp > (1u << 20)) break; }
            __builtin_amdgcn_fence(__ATOMIC_ACQUIRE, "agent"); asm volatile("s_waitcnt vmcnt(0)" ::: "memory"); }
        __syncthreads();
        const int r16 = lane & 15, q4 = lane >> 4, cb0 = (bx - 60) * 2;
        f32x4 pa[2][8];
#pragma unroll
        for (int j = 0; j < 2; ++j)
#pragma unroll
            for (int rbk = 0; rbk < 8; ++rbk) pa[j][rbk] = (f32x4){0.f, 0.f, 0.f, 0.f};
        const bf16* wp = WDN + ((size_t)(16 * cb0 + r16) * FF + 352 * wave + 8 * q4);
        const bf16* ap = ACT + ((size_t)(MP + r16) * FF + 352 * wave + 8 * q4);
#pragma unroll
        for (int ks = 0; ks < 11; ++ks) {
            const bf16x8 wf0 = *(const bf16x8*)(wp + 32 * ks), wf1 = *(const bf16x8*)(wp + (size_t)16 * FF + 32 * ks);
#pragma unroll
            for (int rbk = 0; rbk < 8; ++rbk) { const bf16x8 af = *(const bf16x8*)(ap + (size_t)rbk * 16 * FF + 32 * ks);
                pa[0][rbk] = __builtin_amdgcn_mfma_f32_16x16x32_bf16(wf0, af, pa[0][rbk], 0, 0, 0); pa[1][rbk] = __builtin_amdgcn_mfma_f32_16x16x32_bf16(wf1, af, pa[1][rbk], 0, 0, 0); }
            asm volatile("" ::: "memory");
        }
        LAS f32x4* red = (LAS f32x4*)lds;
#pragma unroll
        for (int j = 0; j < 2; ++j)
#pragma unroll
            for (int rbk = 0; rbk < 8; ++rbk) red[(wave * 16 + j * 8 + rbk) * 64 + lane] = pa[j][rbk];
        __syncthreads();
#pragma unroll
        for (int t = 0; t < 2; ++t) {
            const int b = 2 * wave + t, j = b >> 3, rbk = b & 7;
            f32x4 sm = (f32x4){0.f, 0.f, 0.f, 0.f};
#pragma unroll
            for (int w2 = 0; w2 < 8; ++w2) sm += red[(w2 * 16 + b) * 64 + lane];
            float* p = out + (size_t)(MP + 16 * rbk + r16) * D + 16 * (cb0 + j) + 4 * q4;
            *(f32x4*)p = *(const f32x4*)p + sm;
        }
        __syncthreads();
    }
    xcd_barrier(xbar);

    {
        KArgs k = kargs();
        float* out = k->out; const float* g_fin = KIN(25);
        for (int m = MP + gw; m < MTOT; m += NGW) {
            f32x4* xr4 = (f32x4*)(out + (size_t)m * D) + lane;
            f32x4 v[4]; float sq = 0.f;
#pragma unroll
            for (int j = 0; j < 4; ++j) { v[j] = xr4[64 * j]; sq += (v[j][0] * v[j][0] + v[j][1] * v[j][1]) + (v[j][2] * v[j][2] + v[j][3] * v[j][3]); }
            const float rstd = rsqrtf(wave_sum(sq) * (1.0f / D) + EPS);
#pragma unroll
            for (int j = 0; j < 4; ++j) { const f32x4 gq = ((const f32x4*)g_fin)[lane + 64 * j]; xr4[64 * j] = v[j] * rstd * gq; }
        }
    }
    {
        KArgs k = kargs();
        float* out = k->out; bf16* ACT = WSP(bf16, WS_ACT); bf16* WDN = WSP(bf16, WS_WDN);
        pg8::Gemm g{ACT, WDN, MP, D, FF, FF}; pg8::StaticOrder S; S.init(MP, D, G, bx);
        EpiDownNorm Ep{WSP(bf16, WS_XMIDB), KIN(25), out, WSP(float, WS_XSLOT), WSP(unsigned, WS_CNT)};
        pg8::gemm_phase<EpiDownNorm, pg8::StaticOrder, true, true, 0, true>(lds, g, S, Ep);
    }
}

extern "C" void kernel_launch(void* const* d_in, const int* in_sizes, int n_in, void* d_out, int out_size, void* d_ws, size_t ws_size, hipStream_t stream) {
    static int grid = 0;
    if (grid == 0) {
        int dev = 0, cus = 0, per_cu = 0;
        (void)hipGetDevice(&dev);
        (void)hipDeviceGetAttribute(&cus, hipDeviceAttributeMultiprocessorCount, dev);
        if (hipFuncSetAttribute((const void*)fwd_kernel, hipFuncAttributeMaxDynamicSharedMemorySize, LDS_BYTES) != hipSuccess) { fprintf(stderr, "hipFuncSetAttribute failed\n"); }
        if (hipOccupancyMaxActiveBlocksPerMultiprocessor(&per_cu, (const void*)fwd_kernel, 512, LDS_BYTES) != hipSuccess || per_cu < 1) { fprintf(stderr, "occupancy query: %d\n", per_cu); per_cu = 1; }
        (void)hipGetLastError();
        grid = cus * per_cu;
        if (ws_size < WS_END) fprintf(stderr, "workspace too small: %zu < %zu\n", ws_size, (size_t)WS_END);
    }
    if (hipMemsetAsync((char*)d_ws + WS_BAR, 0, 49152, stream) != hipSuccess) fprintf(stderr, "memset of barrier words failed\n");
    Args a{};
    for (int i = 0; i < 26; ++i) a.in[i] = (const float*)d_in[i];
    a.out = (float*)d_out; a.ws = (unsigned char*)d_ws;
    void* args[] = {&a};
    hipError_t e = hipLaunchCooperativeKernel((const void*)fwd_kernel, dim3(grid), dim3(512), args, LDS_BYTES, stream);
    if (e != hipSuccess) fprintf(stderr, "cooperative launch failed: %s (grid %d)\n", hipGetErrorString(e), grid);
}
```
